# Optimizing an MI355X kernel written in HIP

```python
import math
import jax, jax.numpy as jnp
from jax import lax
import numpy as np

D_MODEL = 1024
BATCH = 8
SEQ = 4096
DEPTH = 2

EPS = 1e-6
MIX_WIDTH = D_MODEL
A_WIDTH = MIX_WIDTH // 2
B_WIDTH = MIX_WIDTH - A_WIDTH
A_GROUPS = 4
A_GROUP_DIM = A_WIDTH // A_GROUPS
CHUNK = 128
B_GROUPS = 8
CONV_W = 3
EVEN_IN_WIDTH = 2 * A_WIDTH + 3 * B_WIDTH
N_HEADS = 16
N_KV_HEADS = 4
Q_PER_KV = N_HEADS // N_KV_HEADS
HEAD_DIM = D_MODEL // N_HEADS
QKV_WIDTH = (N_HEADS + 2 * N_KV_HEADS) * HEAD_DIM
WINDOW = 128
BLOCK = 128
N_BUCKETS = 32
MAX_DISTANCE = 128
D_FF = ((8 * D_MODEL // 3 + 255) // 256) * 256
N_EVEN = (DEPTH + 1) // 2
N_ODD = DEPTH // 2

kernel_name = "hybrid_gmlp_shortconv_swa_encoder"


def rmsnorm(x, g):
    xf = x.astype(jnp.float32)
    y = xf * lax.rsqrt(jnp.mean(xf * xf, axis=-1, keepdims=True) + EPS)
    return (y * g.astype(jnp.float32)).astype(x.dtype)


def layernorm(x, g, b):
    xf = x.astype(jnp.float32)
    mu = jnp.mean(xf, axis=-1, keepdims=True)
    xc = xf - mu
    y = xc * lax.rsqrt(jnp.mean(xc * xc, axis=-1, keepdims=True) + EPS)
    return (y * g.astype(jnp.float32) + b.astype(jnp.float32)).astype(x.dtype)


def t5_buckets(rel):
    nb = N_BUCKETS // 2
    ret = jnp.where(rel > 0, nb, 0)
    n = jnp.abs(rel)
    max_exact = nb // 2
    nf = jnp.maximum(n, 1).astype(jnp.float32)
    large = max_exact + (jnp.log(nf / max_exact) / math.log(MAX_DISTANCE / max_exact)
                         * (nb - max_exact)).astype(jnp.int32)
    large = jnp.minimum(large, nb - 1)
    return ret + jnp.where(n < max_exact, n, large)


def even_mixer(h, w_in, v_ln_g, v_ln_b, w_spatial, b_spatial, conv_w, w_out):
    bsz, s, _ = h.shape
    proj = jnp.einsum('bsd,de->bse', h, w_in)
    a_u, a_v, b_b, b_c, b_h = jnp.split(
        proj, [A_WIDTH, 2 * A_WIDTH, 2 * A_WIDTH + B_WIDTH, 2 * A_WIDTH + 2 * B_WIDTH], axis=-1)
    a_u = jax.nn.gelu(a_u, approximate=False)
    a_v = layernorm(jax.nn.gelu(a_v, approximate=False), v_ln_g, v_ln_b)
    n_chunks = s // CHUNK
    v = a_v.reshape(bsz, n_chunks, CHUNK, A_GROUPS, A_GROUP_DIM)
    mixed = jnp.einsum('gpq,bcqgd->bcpgd', w_spatial, v) + b_spatial.T[None, None, :, :, None]
    a_out = a_u * mixed.reshape(bsz, s, A_WIDTH)
    z = b_c * b_h
    pad = CONV_W // 2
    zp = jnp.pad(z, ((0, 0), (pad, pad), (0, 0)))
    conv = zp[:, 0:s] * conv_w[0]
    for tap in range(1, CONV_W):
        conv = conv + zp[:, tap:tap + s] * conv_w[tap]
    b_out = b_b * conv
    y = jnp.concatenate([a_out, b_out], axis=-1)
    return jnp.einsum('bse,ed->bsd', y, w_out)


def window_attention(h, w_qkv, sink, rel_bias, w_out):
    bsz, s, _ = h.shape
    n_blocks = s // BLOCK
    qkv = jnp.einsum('bsd,de->bse', h, w_qkv)
    q, k, v = jnp.split(qkv, [N_HEADS * HEAD_DIM, (N_HEADS + N_KV_HEADS) * HEAD_DIM], axis=-1)
    q = q.reshape(bsz, n_blocks, BLOCK, N_KV_HEADS, Q_PER_KV, HEAD_DIM).transpose(1, 0, 2, 3, 4, 5)
    k = k.reshape(bsz, s, N_KV_HEADS, HEAD_DIM)
    v = v.reshape(bsz, s, N_KV_HEADS, HEAD_DIM)
    kp = jnp.pad(k, ((0, 0), (BLOCK, BLOCK), (0, 0), (0, 0)))
    vp = jnp.pad(v, ((0, 0), (BLOCK, BLOCK), (0, 0), (0, 0)))
    qi = jnp.arange(BLOCK, dtype=jnp.int32)[:, None]
    kj = jnp.arange(3 * BLOCK, dtype=jnp.int32)[None, :]
    rel = kj - BLOCK - qi
    band = jnp.abs(rel) <= WINDOW
    bias = rel_bias[t5_buckets(rel)].astype(jnp.float32)
    bias = bias.transpose(2, 0, 1).reshape(N_KV_HEADS, Q_PER_KV, BLOCK, 3 * BLOCK)
    sink_l = sink.astype(jnp.float32).reshape(N_KV_HEADS, Q_PER_KV, 1, 1)
    scale = HEAD_DIM ** -0.5

    def attend_block(args):
        n, qb = args
        start = n * BLOCK
        kb = lax.dynamic_slice_in_dim(kp, start, 3 * BLOCK, axis=1)
        vb = lax.dynamic_slice_in_dim(vp, start, 3 * BLOCK, axis=1)
        key_pos = start - BLOCK + kj
        mask = band & (key_pos >= 0) & (key_pos < s)
        sc = jnp.einsum('bqhgd,bkhd->bhgqk', qb, kb).astype(jnp.float32) * scale + bias
        sc = jnp.where(mask, sc, -jnp.inf)
        m = jnp.maximum(jnp.max(sc, axis=-1, keepdims=True), sink_l)
        p = jnp.exp(sc - m)
        p = p / (jnp.sum(p, axis=-1, keepdims=True) + jnp.exp(sink_l - m))
        return jnp.einsum('bhgqk,bkhd->bqhgd', p.astype(vb.dtype), vb)

    out = lax.map(attend_block, (jnp.arange(n_blocks, dtype=jnp.int32), q))
    out = out.transpose(1, 0, 2, 3, 4, 5).reshape(bsz, s, N_HEADS * HEAD_DIM)
    return jnp.einsum('bse,ed->bsd', out, w_out)


def swiglu(h, w_gate, w_up, w_down):
    g = jnp.einsum('bsd,df->bsf', h, w_gate)
    u = jnp.einsum('bsd,df->bsf', h, w_up)
    return jnp.einsum('bsf,fd->bsd', jax.nn.silu(g) * u, w_down)


def setup_inputs(seed: int = 0) -> dict:
    key = jax.random.key(seed)
    ks = jax.random.split(key, 20)
    f32 = jnp.float32
    nrm = lambda k, shape, scale: jax.random.normal(k, shape, f32) * scale
    return {
        "x": nrm(ks[0], (BATCH, SEQ, D_MODEL), 1.0),
        "norm_mix": 1.0 + nrm(ks[1], (DEPTH, D_MODEL), 0.02),
        "norm_ffn": 1.0 + nrm(ks[2], (DEPTH, D_MODEL), 0.02),
        "even_w_in": nrm(ks[3], (N_EVEN, D_MODEL, EVEN_IN_WIDTH), D_MODEL ** -0.5),
        "even_v_ln_g": 1.0 + nrm(ks[4], (N_EVEN, A_WIDTH), 0.02),
        "even_v_ln_b": nrm(ks[5], (N_EVEN, A_WIDTH), 0.02),
        "even_w_spatial": nrm(ks[6], (N_EVEN, A_GROUPS, CHUNK, CHUNK), CHUNK ** -0.5),
        "even_b_spatial": 1.0 + nrm(ks[7], (N_EVEN, A_GROUPS, CHUNK), 0.1),
        "even_conv_w": nrm(ks[8], (N_EVEN, CONV_W, B_WIDTH), CONV_W ** -0.5),
        "even_w_out": nrm(ks[9], (N_EVEN, MIX_WIDTH, D_MODEL), MIX_WIDTH ** -0.5),
        "attn_w_qkv": nrm(ks[10], (N_ODD, D_MODEL, QKV_WIDTH), D_MODEL ** -0.5),
        "attn_sink": nrm(ks[11], (N_ODD, N_HEADS), 0.5),
        "rel_bias": nrm(ks[12], (N_BUCKETS, N_HEADS), 0.5),
        "attn_w_out": nrm(ks[13], (N_ODD, N_HEADS * HEAD_DIM, D_MODEL), (N_HEADS * HEAD_DIM) ** -0.5),
        "ffn_w_gate": nrm(ks[14], (DEPTH, D_MODEL, D_FF), D_MODEL ** -0.5),
        "ffn_w_up": nrm(ks[15], (DEPTH, D_MODEL, D_FF), D_MODEL ** -0.5),
        "ffn_w_down": nrm(ks[16], (DEPTH, D_FF, D_MODEL), D_FF ** -0.5),
        "final_norm": 1.0 + nrm(ks[17], (D_MODEL,), 0.02),
    }


def reference(x, norm_mix, norm_ffn, even_w_in, even_v_ln_g, even_v_ln_b, even_w_spatial,
              even_b_spatial, even_conv_w, even_w_out, attn_w_qkv, attn_sink, rel_bias,
              attn_w_out, ffn_w_gate, ffn_w_up, ffn_w_down, final_norm):
    for layer in range(DEPTH):
        i = layer // 2
        h = rmsnorm(x, norm_mix[layer])
        if layer % 2 == 0:
            x = x + even_mixer(h, even_w_in[i], even_v_ln_g[i], even_v_ln_b[i], even_w_spatial[i],
                               even_b_spatial[i], even_conv_w[i], even_w_out[i])
        else:
            x = x + window_attention(h, attn_w_qkv[i], attn_sink[i], rel_bias, attn_w_out[i])
        h = rmsnorm(x, norm_ffn[layer])
        x = x + swiglu(h, ffn_w_gate[layer], ffn_w_up[layer], ffn_w_down[layer])
    return rmsnorm(x, final_norm)
```

```cpp
#define MK_OPT_PHASES 12
#define MK_ONE_LAUNCH 0

#include <hip/hip_runtime.h>
#include <cstdio>
#include <cstdint>
#include <cmath>

constexpr int BATCH = 8, SEQ = 4096, DM = 1024, MTOK = BATCH * SEQ;
constexpr int AW = 512, BW = 512, NIN = 2560, CHUNK = 128, NGRP = 4;
constexpr int NH = 16, NKV = 4, HD = 64, NQKV = 1536, WIN = 128;
constexpr int DFF = 2816;
constexpr float EPS = 1e-6f;
constexpr size_t MiB = 1u << 20;
namespace pg8 {
#define PG8_LAS __attribute__((address_space(3)))
typedef unsigned short bf16_t;
typedef short bf16x8 __attribute__((ext_vector_type(8)));
typedef float f32x4 __attribute__((ext_vector_type(4)));
typedef unsigned u32x4 __attribute__((ext_vector_type(4)));
constexpr int BM = 256, BK = 64, HALF = 128, HTB = HALF * BK * 2  , STAGE_BYTES = 8 * HTB, NXCD = 8, WGM = 8;

__host__ __device__ __forceinline__ int lds_byte(int r, int c) { const int st = (r >> 4) * 2 + (c >> 5), rr = r & 15, cc = c & 31, ob = rr * 64 + cc * 2; return st * 1024 + (ob ^ (((ob >> 9) & 1) << 5)); }
__host__ __device__ __forceinline__ void stage_rc(int b, int& R, int& C) { const int st = b / 1024, sb = b % 1024, swz = sb ^ (((sb >> 9) & 1) << 5); R = (st >> 1) * 16 + swz / 64; C = (st & 1) * 32 + (swz % 64) / 2; }
__host__ __device__ __forceinline__ int perm32(int rho) { const int n = rho >> 4, i = rho & 15; return 8 * (i >> 2) + 4 * n + (i & 3); }

struct Unit { int pm, pn; };
struct Gemm { const bf16_t* A; const bf16_t* Bt; int M, N, K; };

struct StaticOrder {
    int nM, nN, nwg, G, c;
    __host__ __device__ void init(int M, int N, int G_, int c_) { nM = M / BM; nN = N / BM; nwg = nM * nN; G = G_; c = c_; }
    __host__ __device__ bool next(int i, Unit& u) const {
        const long L = (long)i * G + c; if (L >= nwg) return false;
        int wgid = (int)L; { const int q = nwg / NXCD, r = nwg % NXCD, xcd = wgid % NXCD, off = wgid / NXCD; wgid = (xcd < r ? xcd * (q + 1) : r * (q + 1) + (xcd - r) * q) + off; }
        const int nig = WGM * nN, gid = wgid / nig, fm = gid * WGM, gsz = (nM - fm) < WGM ? (nM - fm) : WGM;
        u.pm = fm + ((wgid % nig) % gsz); u.pn = (wgid % nig) / gsz; return true;
    }
    __device__ __forceinline__ void a_ready(const Unit&) const {}
    __device__ __forceinline__ void done(const Unit&) const {}
};


__device__ __forceinline__ unsigned cvt_pk_bf16(float lo, float hi) { unsigned r; asm volatile("v_cvt_pk_bf16_f32 %0, %1, %2" : "=v"(r) : "v"(lo), "v"(hi)); return r; }
typedef float f32x2 __attribute__((ext_vector_type(2)));
typedef unsigned u32x2 __attribute__((ext_vector_type(2)));
__device__ __forceinline__ f32x2 gelu_pk(f32x2 v) {
    const f32x2 av = __builtin_elementwise_abs(v), d = av * 0.2316418882f + 1.0f;
    f32x2 t; t.x = __builtin_amdgcn_rcpf(d.x); t.y = __builtin_amdgcn_rcpf(d.y);
    f32x2 q = t * 0.5307027145f + (-0.7265760135f); q = q * t + 0.7107068705f; q = q * t + (-0.142248368f); q = q * t + 0.127414796f; q = q * t;
    const f32x2 s = (v * v) * (-0.72134752044f);
    f32x2 e; e.x = __builtin_amdgcn_exp2f(s.x); e.y = __builtin_amdgcn_exp2f(s.y);
    const f32x2 m = v * (q * e), r = v - m;
    f32x2 o; o.x = v.x < 0.f ? m.x : r.x; o.y = v.y < 0.f ? m.y : r.y; return o;
}
__device__ __forceinline__ f32x4 gelu4(f32x4 v) { const f32x2 a = gelu_pk((f32x2){v[0], v[1]}), b = gelu_pk((f32x2){v[2], v[3]}); return (f32x4){a.x, a.y, b.x, b.y}; }
__device__ __forceinline__ float silu1(float g) { return g * __builtin_amdgcn_rcpf(1.0f + __builtin_amdgcn_exp2f(g * -1.4426950408889634f)); }
constexpr float RMS_EPS = 1e-6f;
constexpr int SSQ_SLOTS = 16;
__device__ __forceinline__ float row_rstd(const float* ssq, int r) {
    const f32x4* p = (const f32x4*)(ssq + (size_t)r * SSQ_SLOTS);
    const f32x4 a = p[0], b = p[1], c = p[2], d = p[3];
    const float s = ((a[0] + a[1]) + (a[2] + a[3])) + ((b[0] + b[1]) + (b[2] + b[3])) + ((c[0] + c[1]) + (c[2] + c[3])) + ((d[0] + d[1]) + (d[2] + d[3]));
    return 1.0f / sqrtf(s * (1.0f / 1024.0f) + RMS_EPS);
}
struct RstdTab {
    const PG8_LAS float* tab; int pmA;
    __device__ __forceinline__ float get(int pm, int rl) const { return tab[(pm != pmA ? 256 : 0) + rl]; }
};
template <class Sched> __device__ __forceinline__ RstdTab fill_rstd_tab(PG8_LAS float* tab, const float* ssq, const Sched& S) {
    Unit u0, u1, t; int pmA = 0, pmB = 0;
    if (S.next(0, u0)) { pmA = u0.pm; pmB = u0.pm; for (int i = 1; S.next(i, t); ++i) pmB = t.pm; }
    const int tid = threadIdx.x, pm = tid < 256 ? pmA : pmB;
    tab[tid] = row_rstd(ssq, pm * BM + (tid & 255));
    __syncthreads();
    RstdTab T; T.tab = tab; T.pmA = pmA; return T;
}
__device__ __forceinline__ u32x4 pack8(f32x4 a, f32x4 b) { u32x4 w; w.x = cvt_pk_bf16(a[0], a[1]); w.y = cvt_pk_bf16(a[2], a[3]); w.z = cvt_pk_bf16(b[0], b[1]); w.w = cvt_pk_bf16(b[2], b[3]); return w; }

struct EpiMix1 {
    static constexpr bool PERM = true, AFTER_DRAIN = false;
    RstdTab T; bf16_t* U4; float* vst;
    __device__ __forceinline__ void init(f32x4 (&acc)[2][2][4][2], const Unit&, int, int, int, int) const {
#pragma unroll
        for (int a = 0; a < 2; ++a)
#pragma unroll
            for (int b = 0; b < 2; ++b)
#pragma unroll
                for (int m = 0; m < 4; ++m)
#pragma unroll
                    for (int n = 0; n < 2; ++n) acc[a][b][m][n] = (f32x4){0.f, 0.f, 0.f, 0.f};
    }
    __device__ __forceinline__ void operator()(const f32x4 (&acc)[2][2][4][2], const Unit& u, int wr, int wc, int fr, int fq) const {
        const int row0 = u.pm * BM + wr * 64 + fr, pn = u.pn, cl = wc * 32 + 8 * fq;
        float rs[2][4];
#pragma unroll
        for (int ai = 0; ai < 2; ++ai)
#pragma unroll
            for (int m = 0; m < 4; ++m) rs[ai][m] = T.get(u.pm, wr * 64 + fr + ai * HALF + m * 16);
        if (pn < 6) {
            bf16_t* base = U4 + (size_t)(pn >> 1) * ((size_t)32768 * 512); const int colt = (pn & 1) * 256 + cl;
#pragma unroll
            for (int ai = 0; ai < 2; ++ai)
#pragma unroll
                for (int m = 0; m < 4; ++m) { const int r = row0 + ai * HALF + m * 16; const float s = rs[ai][m]; float s1 = 0.f, s2 = 0.f;
#pragma unroll
                    for (int bj = 0; bj < 2; ++bj) { f32x4 v0 = acc[ai][bj][m][0] * s, v1 = acc[ai][bj][m][1] * s;
                        if (pn < 4) { v0 = gelu4(v0); v1 = gelu4(v1); }
                        if (pn == 2 || pn == 3) { s1 += ((v0[0] + v0[1]) + (v0[2] + v0[3])) + ((v1[0] + v1[1]) + (v1[2] + v1[3]));
                            s2 += ((v0[0] * v0[0] + v0[1] * v0[1]) + (v0[2] * v0[2] + v0[3] * v0[3])) + ((v1[0] * v1[0] + v1[1] * v1[1]) + (v1[2] * v1[2] + v1[3] * v1[3])); }
                        *(u32x4*)(base + (size_t)r * 512 + colt + bj * HALF) = pack8(v0, v1); }
                    if (pn == 2 || pn == 3) { s1 += __shfl_xor(s1, 16); s1 += __shfl_xor(s1, 32); s2 += __shfl_xor(s2, 16); s2 += __shfl_xor(s2, 32);
                        if (fq == 0) *(f32x2*)(vst + (size_t)r * 16 + ((pn - 2) * 4 + wc) * 2) = (f32x2){s1, s2}; } }
        } else {
            const int colt = (pn - 6) * 128 + cl;
#pragma unroll
            for (int ai = 0; ai < 2; ++ai)
#pragma unroll
                for (int m = 0; m < 4; ++m) { const int r = row0 + ai * HALF + m * 16; const float s2 = rs[ai][m] * rs[ai][m];
                    const f32x4 z0 = acc[ai][0][m][0] * acc[ai][1][m][0] * s2, z1 = acc[ai][0][m][1] * acc[ai][1][m][1] * s2;
                    *(u32x4*)(U4 + (size_t)3 * ((size_t)32768 * 512) + (size_t)r * 512 + colt) = pack8(z0, z1); }
        }
    }
};

struct EpiRes {
    static constexpr bool PERM = false, AFTER_DRAIN = false;
    const float* res; float* out; bf16_t* xb; float* ssq;
    __device__ __forceinline__ void init(f32x4 (&acc)[2][2][4][2], const Unit& u, int wr, int wc, int fr, int fq) const {
        const int row0 = u.pm * BM + wr * 64 + fr, col0 = u.pn * BM + wc * 32 + 4 * fq;
#pragma unroll
        for (int ai = 0; ai < 2; ++ai)
#pragma unroll
            for (int bj = 0; bj < 2; ++bj)
#pragma unroll
                for (int m = 0; m < 4; ++m)
#pragma unroll
                    for (int n = 0; n < 2; ++n) acc[ai][bj][m][n] = *(const f32x4*)(res + (size_t)(row0 + ai * HALF + m * 16) * 1024 + col0 + bj * HALF + n * 16);
    }
    __device__ __forceinline__ void operator()(const f32x4 (&acc)[2][2][4][2], const Unit& u, int wr, int wc, int fr, int fq) const {
        const int row0 = u.pm * BM + wr * 64 + fr, col0 = u.pn * BM + wc * 32 + 4 * fq;
#pragma unroll
        for (int ai = 0; ai < 2; ++ai)
#pragma unroll
            for (int m = 0; m < 4; ++m) { const int r = row0 + ai * HALF + m * 16; const size_t off = (size_t)r * 1024 + col0; float ss = 0.f;
#pragma unroll
                for (int bj = 0; bj < 2; ++bj)
#pragma unroll
                    for (int n = 0; n < 2; ++n) { const f32x4 v = acc[ai][bj][m][n];
                        *(f32x4*)(out + off + bj * HALF + n * 16) = v;
                        u32x2 w; w.x = cvt_pk_bf16(v[0], v[1]); w.y = cvt_pk_bf16(v[2], v[3]); *(u32x2*)(xb + off + bj * HALF + n * 16) = w;
                        ss += (v[0] * v[0] + v[1] * v[1]) + (v[2] * v[2] + v[3] * v[3]); }
                ss += __shfl_xor(ss, 16); ss += __shfl_xor(ss, 32);
                if (fq == 0) ssq[(size_t)r * SSQ_SLOTS + u.pn * 4 + wc] = ss; }
    }
};

struct EpiSwiglu {
    static constexpr bool PERM = true, AFTER_DRAIN = false;
    RstdTab T; bf16_t* act;
    __device__ __forceinline__ void init(f32x4 (&acc)[2][2][4][2], const Unit&, int, int, int, int) const {
#pragma unroll
        for (int a = 0; a < 2; ++a)
#pragma unroll
            for (int b = 0; b < 2; ++b)
#pragma unroll
                for (int m = 0; m < 4; ++m)
#pragma unroll
                    for (int n = 0; n < 2; ++n) acc[a][b][m][n] = (f32x4){0.f, 0.f, 0.f, 0.f};
    }
    __device__ __forceinline__ void operator()(const f32x4 (&acc)[2][2][4][2], const Unit& u, int wr, int wc, int fr, int fq) const {
        const int row0 = u.pm * BM + wr * 64 + fr, colt = u.pn * 128 + wc * 32 + 8 * fq;
#pragma unroll
        for (int ai = 0; ai < 2; ++ai)
#pragma unroll
            for (int m = 0; m < 4; ++m) { const int r = row0 + ai * HALF + m * 16; const float s = T.get(u.pm, wr * 64 + fr + ai * HALF + m * 16);
                f32x4 o[2];
#pragma unroll
                for (int n = 0; n < 2; ++n) { const f32x4 g = acc[ai][0][m][n] * s, up = acc[ai][1][m][n] * s;
                    o[n] = (f32x4){silu1(g[0]) * up[0], silu1(g[1]) * up[1], silu1(g[2]) * up[2], silu1(g[3]) * up[3]}; }
                *(u32x4*)(act + (size_t)r * 2816 + colt) = pack8(o[0], o[1]); }
    }
};

struct EpiQKV {
    static constexpr bool PERM = true, AFTER_DRAIN = false;
    RstdTab T; bf16_t* Q;
    __device__ __forceinline__ void init(f32x4 (&acc)[2][2][4][2], const Unit&, int, int, int, int) const {
#pragma unroll
        for (int a = 0; a < 2; ++a)
#pragma unroll
            for (int b = 0; b < 2; ++b)
#pragma unroll
                for (int m = 0; m < 4; ++m)
#pragma unroll
                    for (int n = 0; n < 2; ++n) acc[a][b][m][n] = (f32x4){0.f, 0.f, 0.f, 0.f};
    }
    __device__ __forceinline__ void operator()(const f32x4 (&acc)[2][2][4][2], const Unit& u, int wr, int wc, int fr, int fq) const {
        const int row0 = u.pm * BM + wr * 64 + fr, pn = u.pn, cl = wc * 32 + 8 * fq;
        bf16_t* base = pn < 4 ? Q + pn * 256 : Q + (size_t)32768 * 1024 + (size_t)(pn - 4) * ((size_t)32768 * 256); const int ld = pn < 4 ? 1024 : 256;
#pragma unroll
        for (int ai = 0; ai < 2; ++ai)
#pragma unroll
            for (int m = 0; m < 4; ++m) { const int r = row0 + ai * HALF + m * 16; const float s = T.get(u.pm, wr * 64 + fr + ai * HALF + m * 16);
#pragma unroll
                for (int bj = 0; bj < 2; ++bj) *(u32x4*)(base + (size_t)r * ld + cl + bj * HALF) = pack8(acc[ai][bj][m][0] * s, acc[ai][bj][m][1] * s); }
    }
};

template <class Epi, class Sched, bool ALIGN_EPI = false, bool SP2 = false>
__device__ __forceinline__ void gemm_phase(PG8_LAS unsigned char* lds, const Gemm g, const Sched& S, const Epi& E) {
    const int tid = threadIdx.x, wid = __builtin_amdgcn_readfirstlane(tid >> 6), lane = tid & 63, wr = wid >> 2, wc = wid & 3, fr = lane & 15, fq = lane >> 4;
    const int K = g.K, nt = K / BK;
    unsigned voffA[2], voffB[2];
#pragma unroll
    for (int i = 0; i < 2; ++i) { int R, C; stage_rc(tid * 16 + i * 8192, R, C); const int Rb = Epi::PERM ? ((R & ~31) + perm32(R & 31)) : R;
        voffA[i] = (unsigned)(R * K + C) * 2u; voffB[i] = (unsigned)(Rb * K + C) * 2u; }
    const size_t kstep = (size_t)(BK * 2);
    const size_t hstep = (size_t)HALF * K * 2;
    const size_t tstep = 2 * hstep;
    const unsigned ldsw = (unsigned)wid * 1024u;
    const int aoff = lds_byte(wr * 64 + fr, fq * 8), boff = lds_byte(wc * 32 + fr, fq * 8);
#define PG8_SA(b, h) (((b) * 2 + (h)) * HTB)
#define PG8_SB(b, h) ((4 + (b) * 2 + (h)) * HTB)
#define PG8_STAGE(bufoff, gbase, voff) do { _Pragma("unroll") for (int _i = 0; _i < 2; ++_i) \
        __builtin_amdgcn_global_load_lds((const unsigned*)((const char*)(gbase) + (voff)[_i]), (PG8_LAS unsigned*)(lds + (bufoff) + ldsw + _i * 8192), 16, 0, 0); } while (0)
#define PG8_LDA(dst, b, h) do { _Pragma("unroll") for (int m = 0; m < 4; ++m) _Pragma("unroll") for (int k = 0; k < 2; ++k) dst[m][k] = *(const PG8_LAS bf16x8*)(lds + PG8_SA(b, h) + aoff + m * 2048 + k * 1024); } while (0)
#define PG8_LDB(dst, b, h) do { _Pragma("unroll") for (int n = 0; n < 2; ++n) _Pragma("unroll") for (int k = 0; k < 2; ++k) dst[n][k] = *(const PG8_LAS bf16x8*)(lds + PG8_SB(b, h) + boff + n * 2048 + k * 1024); } while (0)
#define PG8_MMA(ai, bj, At, Bt) do { __builtin_amdgcn_s_setprio(1); _Pragma("unroll") for (int m = 0; m < 4; ++m) _Pragma("unroll") for (int n = 0; n < 2; ++n) _Pragma("unroll") for (int k = 0; k < 2; ++k) \
        acc[ai][bj][m][n] = __builtin_amdgcn_mfma_f32_16x16x32_bf16(Bt[n][k], At[m][k], acc[ai][bj][m][n], 0, 0, 0); __builtin_amdgcn_s_setprio(0); } while (0)
#define PG8_WAIT_V(n) asm volatile("s_waitcnt vmcnt(" #n ")" ::: "memory")
#define PG8_WAIT_L(n) asm volatile("s_waitcnt lgkmcnt(" #n ")" ::: "memory")
#define PG8_BAR __builtin_amdgcn_s_barrier()
#define PG8_SCHED __builtin_amdgcn_sched_barrier(0)
    Unit cur, nxt; int ui = 0;
    if (!S.next(0, cur)) return;
    f32x4 acc[2][2][4][2];
    E.init(acc, cur, wr, wc, fr, fq);
    bf16x8 At[4][2], B0[2][2], B1[2][2];
    const char* cA = (const char*)g.A + (size_t)cur.pm * tstep; const char* cB = (const char*)g.Bt + (size_t)cur.pn * tstep;
    S.a_ready(cur);
    if constexpr (SP2) {
        PG8_STAGE(PG8_SB(0, 0), cB, voffB); PG8_STAGE(PG8_SB(0, 1), cB + hstep, voffB); PG8_STAGE(PG8_SA(0, 0), cA, voffA); PG8_STAGE(PG8_SA(0, 1), cA + hstep, voffA);
        if (wr == 1) PG8_BAR;
        PG8_WAIT_V(2); PG8_BAR;
        PG8_STAGE(PG8_SB(1, 0), cB + kstep, voffB); PG8_STAGE(PG8_SA(1, 0), cA + kstep, voffA); PG8_STAGE(PG8_SB(1, 1), cB + hstep + kstep, voffB);
        PG8_WAIT_V(6); PG8_BAR;
    } else {
        PG8_STAGE(PG8_SB(0, 0), cB, voffB); PG8_STAGE(PG8_SA(0, 0), cA, voffA); PG8_STAGE(PG8_SB(0, 1), cB + hstep, voffB); PG8_STAGE(PG8_SA(0, 1), cA + hstep, voffA);
        if (wr == 1) PG8_BAR;
        PG8_WAIT_V(4); PG8_BAR;
        PG8_STAGE(PG8_SB(1, 0), cB + kstep, voffB); PG8_STAGE(PG8_SA(1, 0), cA + kstep, voffA); PG8_STAGE(PG8_SB(1, 1), cB + hstep + kstep, voffB);
        PG8_WAIT_V(6); PG8_BAR;
    }
    for (;;) {
        const bool has_next = S.next(ui + 1, nxt);
        const char* nA = has_next ? (const char*)g.A + (size_t)nxt.pm * tstep : cA; const char* nB = has_next ? (const char*)g.Bt + (size_t)nxt.pn * tstep : cB;
        for (int t = 0; t < nt; t += 2) {
            const bool last = (t == nt - 2);
            const char* a1 = cA + (size_t)(t + 1) * kstep;
            const char* a2 = last ? nA : cA + (size_t)(t + 2) * kstep; const char* b2 = last ? nB : cB + (size_t)(t + 2) * kstep;
            const char* a3 = a2 + kstep; const char* b3 = b2 + kstep;
            if (last && has_next) S.a_ready(nxt);
            if constexpr (SP2) {
            PG8_LDB(B0, 0, 0); PG8_LDB(B1, 0, 1); PG8_SCHED; PG8_LDA(At, 0, 0); PG8_STAGE(PG8_SA(1, 1), a1 + hstep, voffA);
            PG8_WAIT_V(8); PG8_WAIT_L(0); PG8_BAR; PG8_MMA(0, 0, At, B0); PG8_MMA(0, 1, At, B1); PG8_BAR; PG8_SCHED;
            PG8_LDA(At, 0, 1); PG8_STAGE(PG8_SB(0, 0), b2, voffB); PG8_STAGE(PG8_SB(0, 1), b2 + hstep, voffB); PG8_STAGE(PG8_SA(0, 0), a2, voffA);
            PG8_WAIT_V(8); PG8_WAIT_L(0); PG8_BAR; PG8_MMA(1, 0, At, B0); PG8_MMA(1, 1, At, B1); PG8_BAR; PG8_SCHED;
            PG8_LDB(B0, 1, 0); PG8_LDB(B1, 1, 1); PG8_SCHED; PG8_LDA(At, 1, 0); PG8_STAGE(PG8_SA(0, 1), a2 + hstep, voffA);
            PG8_WAIT_V(8); PG8_WAIT_L(0); PG8_BAR; PG8_MMA(0, 0, At, B0); PG8_MMA(0, 1, At, B1); PG8_BAR; PG8_SCHED;
            PG8_LDA(At, 1, 1); PG8_STAGE(PG8_SB(1, 0), b3, voffB); PG8_STAGE(PG8_SB(1, 1), b3 + hstep, voffB); PG8_STAGE(PG8_SA(1, 0), a3, voffA);
            PG8_WAIT_V(8); PG8_WAIT_L(0); PG8_BAR; PG8_MMA(1, 0, At, B0); PG8_MMA(1, 1, At, B1); PG8_BAR; PG8_SCHED;
            } else {
            PG8_LDB(B0, 0, 0); PG8_SCHED; PG8_LDA(At, 0, 0); PG8_STAGE(PG8_SA(1, 1), a1 + hstep, voffA);
            PG8_WAIT_L(8); PG8_BAR; PG8_WAIT_L(0); PG8_MMA(0, 0, At, B0); PG8_BAR; PG8_SCHED;
            PG8_LDB(B1, 0, 1); PG8_STAGE(PG8_SB(0, 0), b2, voffB);
            PG8_BAR; PG8_WAIT_L(0); PG8_MMA(0, 1, At, B1); PG8_BAR;
            PG8_LDA(At, 0, 1); PG8_STAGE(PG8_SA(0, 0), a2, voffA);
            PG8_BAR; PG8_WAIT_L(0); PG8_MMA(1, 0, At, B0); PG8_BAR; PG8_SCHED;
            PG8_STAGE(PG8_SB(0, 1), b2 + hstep, voffB);
            PG8_WAIT_V(6); PG8_BAR; PG8_MMA(1, 1, At, B1); PG8_BAR;
            PG8_LDB(B0, 1, 0); PG8_SCHED; PG8_LDA(At, 1, 0); PG8_STAGE(PG8_SA(0, 1), a2 + hstep, voffA);
            PG8_WAIT_L(8); PG8_BAR; PG8_WAIT_L(0); PG8_MMA(0, 0, At, B0); PG8_BAR; PG8_SCHED;
            PG8_LDB(B1, 1, 1); PG8_STAGE(PG8_SB(1, 0), b3, voffB);
            PG8_BAR; PG8_WAIT_L(0); PG8_MMA(0, 1, At, B1); PG8_BAR;
            PG8_LDA(At, 1, 1); PG8_STAGE(PG8_SA(1, 0), a3, voffA);
            PG8_BAR; PG8_WAIT_L(0); PG8_MMA(1, 0, At, B0); PG8_BAR; PG8_SCHED;
            PG8_STAGE(PG8_SB(1, 1), b3 + hstep, voffB);
            PG8_WAIT_V(6); PG8_BAR; PG8_MMA(1, 1, At, B1); PG8_BAR;
            }
        }
        if constexpr (ALIGN_EPI) { if (wr == 0) PG8_BAR; }
        if constexpr (!Epi::AFTER_DRAIN) { E(acc, cur, wr, wc, fr, fq); S.done(cur); }
        if (!has_next) break;
        E.init(acc, nxt, wr, wc, fr, fq);
        cur = nxt; cA = nA; cB = nB; ++ui;
        if constexpr (ALIGN_EPI) { if (wr == 1) PG8_BAR; }
    }
    PG8_WAIT_V(0);
    if constexpr (!ALIGN_EPI) { if (wr == 0) PG8_BAR; }
    PG8_BAR;
    if constexpr (Epi::AFTER_DRAIN) { E.fused(acc, cur, wr, wc, fr, fq, lds, wid, lane); S.done(cur); }
#undef PG8_SA
#undef PG8_SB
#undef PG8_STAGE
#undef PG8_LDA
#undef PG8_LDB
#undef PG8_MMA
#undef PG8_WAIT_V
#undef PG8_WAIT_L
#undef PG8_BAR
#undef PG8_SCHED
}
}

namespace att {
#define ALDS __attribute__((address_space(3)))
typedef unsigned short bf16_t;
typedef short bf16x8 __attribute__((ext_vector_type(8)));
typedef short s16x4 __attribute__((ext_vector_type(4)));
typedef float f32x16 __attribute__((ext_vector_type(16)));
typedef float f32x4 __attribute__((ext_vector_type(4)));
typedef unsigned u32x4 __attribute__((ext_vector_type(4)));
constexpr int SEQ_ = 4096, NKVH = 4, SLOT = 16384, NSLOT = 5, BT = 392;
constexpr int L_KV = 0, L_BIAS = NSLOT * SLOT, L_WS = L_BIAS + 4 * 4 * BT * 4, L_OST = L_WS + 8 * 64 * 4, L_END = L_OST + 8 * 4096;
constexpr float LOG2E = 1.4426950408889634f;
__device__ __forceinline__ int crow(int r, int hi) { return (r & 3) + 8 * (r >> 2) + 4 * hi; }
__device__ __forceinline__ int t5_bucket(int rel) {
    const int n = rel < 0 ? -rel : rel; int b;
    if (n < 8) b = n; else { const int lg = 31 - __clz(n * n); b = 8 + (lg - 6); if (b > 15) b = 15; }
    return (rel > 0 ? 16 : 0) + b;
}
__device__ __forceinline__ unsigned cvtpk(float lo, float hi) { unsigned r; asm volatile("v_cvt_pk_bf16_f32 %0, %1, %2" : "=v"(r) : "v"(lo), "v"(hi)); return r; }
__device__ __forceinline__ s16x4 vtr(const ALDS unsigned char* p) { typedef short v4i16_t __attribute__((ext_vector_type(4))); return __builtin_bit_cast(s16x4, __builtin_amdgcn_ds_read_tr16_b64_v4i16((ALDS v4i16_t*)p)); }

__device__ __forceinline__ void att_phase(ALDS unsigned char* lds, const bf16_t* Q, const bf16_t* K, const bf16_t* V, bf16_t* O, const float* sink, const float* relb, int vcu, int G) {
    const int tid = threadIdx.x, lane = tid & 63, r32 = lane & 31, hi = lane >> 5, wid = __builtin_amdgcn_readfirstlane(tid >> 6);
    const int NUNIT = 8 * NKVH * (SEQ_ / 64);
    const int upc = (NUNIT + G - 1) / G;
    ALDS float* wsf = (ALDS float*)(lds + L_WS) + wid * 64;
    int cur_pair = -1;
    for (int i = 0; i < upc; ++i) {
        const int unit = vcu * upc + i; if (unit >= NUNIT) break;
        const int pair = unit >> 6, qb = unit & 63, b = pair >> 2, kvh = pair & 3;
        __syncthreads();
        if (pair != cur_pair) {
            for (int idx = tid; idx < 4 * 4 * BT; idx += 512) { const int hd = idx / (4 * BT), rem = idx - hd * 4 * BT, s = rem / BT, j = rem - s * BT, rel = j - s - 192;
                float v = -1e30f; if (rel >= -128 && rel <= 128) v = relb[t5_bucket(rel) * 16 + kvh * 4 + hd] * LOG2E;
                ((ALDS float*)(lds + L_BIAS))[idx] = v; }
            cur_pair = pair; }
        const int t_lo = qb - 2 < 0 ? 0 : qb - 2, t_hi = qb + 2 > 63 ? 63 : qb + 2;
        const size_t rowbase = (size_t)b * SEQ_;
        for (int t = t_lo; t <= t_hi; ++t) { const int s = t - (qb - 2);
            const u32x4 kv = *(const u32x4*)(K + (rowbase + 64 * t + lane) * 256 + kvh * 64 + wid * 8);
            const u32x4 vv = *(const u32x4*)(V + (rowbase + 64 * t + 16 * (wid & 3) + (lane >> 2)) * 256 + kvh * 64 + (wid >> 2) * 32 + (lane & 3) * 8);
            *(ALDS u32x4*)(lds + s * SLOT + wid * 1024 + lane * 16) = kv;
            *(ALDS u32x4*)(lds + s * SLOT + 8192 + wid * 1024 + lane * 16) = vv; }
        const int head = kvh * 4 + (wid & 3), q0w = qb * 64 + (wid >> 2) * 32;
        bf16x8 qr[4];
#pragma unroll
        for (int d0 = 0; d0 < 4; ++d0) qr[d0] = *(const bf16x8*)(Q + (rowbase + q0w + r32) * 1024 + head * 64 + d0 * 16 + hi * 8);
        __syncthreads();
        float m = sink[head] * LOG2E, l = hi == 0 ? 1.f : 0.f;
        f32x16 o0, o1;
#pragma unroll
        for (int r = 0; r < 16; ++r) { o0[r] = 0.f; o1[r] = 0.f; }
        const ALDS float* tb = (const ALDS float*)(lds + L_BIAS) + ((wid & 3) * 4 + (r32 & 3)) * BT;
        for (int t = t_lo; t <= t_hi; ++t) {
            const ALDS unsigned char* Ks = lds + (t - (qb - 2)) * SLOT; const ALDS unsigned char* Vs = Ks + 8192;
            f32x16 p0, p1;
#pragma unroll
            for (int r = 0; r < 16; ++r) { p0[r] = 0.f; p1[r] = 0.f; }
#pragma unroll
            for (int d0 = 0; d0 < 4; ++d0) {
                const bf16x8 b0 = *(const ALDS bf16x8*)(Ks + hi * 1024 + r32 * 16 + d0 * 2048);
                const bf16x8 b1 = *(const ALDS bf16x8*)(Ks + hi * 1024 + r32 * 16 + d0 * 2048 + 512);
                p0 = __builtin_amdgcn_mfma_f32_32x32x16_bf16(b0, qr[d0], p0, 0, 0, 0);
                p1 = __builtin_amdgcn_mfma_f32_32x32x16_bf16(b1, qr[d0], p1, 0, 0, 0); }
            const int ib = 64 * t - q0w + 192 - (r32 & ~3) + 4 * hi;
#pragma unroll
            for (int g = 0; g < 4; ++g) { const f32x4 f0 = *(const ALDS f32x4*)(tb + ib + 8 * g), f1 = *(const ALDS f32x4*)(tb + ib + 32 + 8 * g);
#pragma unroll
                for (int e = 0; e < 4; ++e) { p0[4 * g + e] += f0[e]; p1[4 * g + e] += f1[e]; } }
            float rm = fmaxf(p0[0], p1[0]);
#pragma unroll
            for (int r = 1; r < 16; ++r) rm = fmaxf(rm, fmaxf(p0[r], p1[r]));
            rm = fmaxf(rm, __shfl_xor(rm, 32));
            const float mn = fmaxf(m, rm), alpha = __builtin_amdgcn_exp2f(m - mn); m = mn;
            float ps = 0.f;
#pragma unroll
            for (int r = 0; r < 16; ++r) { p0[r] = __builtin_amdgcn_exp2f(p0[r] - mn); p1[r] = __builtin_amdgcn_exp2f(p1[r] - mn); ps += p0[r] + p1[r]; }
            l = l * alpha + ps;
            if (hi == 0) wsf[r32] = alpha;
#pragma unroll
            for (int r = 0; r < 16; ++r) { const float a = wsf[crow(r, hi)]; o0[r] *= a; o1[r] *= a; }
            u32x4 pw[4];
#pragma unroll
            for (int k = 0; k < 2; ++k) { pw[k] = (u32x4){cvtpk(p0[8 * k], p0[8 * k + 1]), cvtpk(p0[8 * k + 2], p0[8 * k + 3]), cvtpk(p0[8 * k + 4], p0[8 * k + 5]), cvtpk(p0[8 * k + 6], p0[8 * k + 7])};
                pw[2 + k] = (u32x4){cvtpk(p1[8 * k], p1[8 * k + 1]), cvtpk(p1[8 * k + 2], p1[8 * k + 3]), cvtpk(p1[8 * k + 4], p1[8 * k + 5]), cvtpk(p1[8 * k + 6], p1[8 * k + 7])}; }
            const ALDS unsigned char* vp = Vs + ((lane >> 4) & 1) * 32 + (lane & 3) * 8 + (4 * hi + ((lane & 15) >> 2)) * 64;
#pragma unroll
            for (int ks = 0; ks < 4; ++ks) { const bf16x8 pa = __builtin_bit_cast(bf16x8, pw[ks]);
                { const s16x4 lo = vtr(vp + ks * 1024), hh = vtr(vp + ks * 1024 + 512); const bf16x8 vf = (bf16x8){lo[0], lo[1], lo[2], lo[3], hh[0], hh[1], hh[2], hh[3]};
                  o0 = __builtin_amdgcn_mfma_f32_32x32x16_bf16(pa, vf, o0, 0, 0, 0); }
                { const s16x4 lo = vtr(vp + 4096 + ks * 1024), hh = vtr(vp + 4096 + ks * 1024 + 512); const bf16x8 vf = (bf16x8){lo[0], lo[1], lo[2], lo[3], hh[0], hh[1], hh[2], hh[3]};
                  o1 = __builtin_amdgcn_mfma_f32_32x32x16_bf16(pa, vf, o1, 0, 0, 0); } }
        }
        l += __shfl_xor(l, 32);
        if (hi == 0) wsf[32 + r32] = l;
        ALDS bf16_t* stg = (ALDS bf16_t*)(lds + L_OST) + wid * 2048;
#pragma unroll
        for (int r = 0; r < 16; ++r) { const int orow = crow(r, hi); const float rl = __builtin_amdgcn_rcpf(wsf[32 + orow]);
            const unsigned a = cvtpk(o0[r] * rl, o1[r] * rl);
            stg[orow * 64 + r32] = (bf16_t)(a & 0xffffu); stg[orow * 64 + 32 + r32] = (bf16_t)(a >> 16); }
        bf16_t* Ow = O + (rowbase + q0w) * 1024 + head * 64;
#pragma unroll
        for (int j = 0; j < 4; ++j) { const int row = j * 8 + (lane >> 3), ch = lane & 7; const u32x4 v = *(const ALDS u32x4*)(stg + row * 64 + ch * 8); *(u32x4*)(Ow + (size_t)row * 1024 + ch * 8) = v; }
    }
    __syncthreads();
}
#undef ALDS
}

constexpr int NWAVES = 8;
constexpr int N_PHASES = 12;

constexpr size_t WS_CTL = 0, CTL_ZERO_BYTES = 1 * MiB;
constexpr size_t WS_WIN = 2 * MiB, WS_WO0 = 7 * MiB, WS_WGU0 = 9 * MiB, WS_WD0 = 20 * MiB, WS_WQKV = 26 * MiB, WS_WO1 = 29 * MiB, WS_WGU1 = 31 * MiB, WS_WD1 = 42 * MiB;
constexpr size_t WS_WSP = 48 * MiB;
constexpr size_t WS_SSQ = 49 * MiB;
constexpr size_t WS_VST = 51 * MiB;
constexpr size_t WS_XB = 56 * MiB;
constexpr size_t WS_A = 128 * MiB;
constexpr size_t WS_U = WS_A, WS_V = WS_A + 32 * MiB, WS_BB = WS_A + 64 * MiB, WS_Z = WS_A + 96 * MiB, WS_Y = WS_A + 128 * MiB;
constexpr size_t WS_ACT = WS_A;
constexpr size_t WS_Q = WS_A, WS_K = WS_A + 64 * MiB, WS_VV = WS_A + 80 * MiB, WS_O = WS_A + 96 * MiB;
constexpr size_t WS_OPT_END = 320 * MiB;
constexpr int CW_TMO = 0, CW_CODE = 1;
constexpr int CW_BAR = 4096;

constexpr int RING_OFF = 0, RING_BYTES = 131072;
constexpr int RSTD_OFF = 150528;
constexpr int MISC_OFF = 153600;
constexpr int LDS_BYTES = 155648;
static_assert(WS_V - WS_U == (size_t)MTOK * 512 * 2 && WS_BB - WS_V == WS_V - WS_U && WS_Z - WS_BB == WS_V - WS_U && WS_K - WS_Q == (size_t)MTOK * 1024 * 2 && WS_VV - WS_K == (size_t)MTOK * 256 * 2, "tensor strides the epilogues assume");
static_assert(att::L_END <= RSTD_OFF && RSTD_OFF + 2048 <= MISC_OFF && MISC_OFF + 128 <= LDS_BYTES, "LDS map");

#define GAS __attribute__((address_space(1)))
#define LAS __attribute__((address_space(3)))
typedef unsigned short bf16;
typedef unsigned v4u __attribute__((ext_vector_type(4)));
typedef unsigned v2u __attribute__((ext_vector_type(2)));
typedef float f32x4 __attribute__((ext_vector_type(4)));
typedef short bf16x8 __attribute__((ext_vector_type(8)));
typedef GAS unsigned gu32;
typedef GAS unsigned long long gu64;
#define RLX_AGENT __ATOMIC_RELAXED, __HIP_MEMORY_SCOPE_AGENT
#define LDS_WAIT() asm volatile("s_waitcnt lgkmcnt(0)" ::: "memory")
#define VM_WAIT() asm volatile("s_waitcnt vmcnt(0)" ::: "memory")
__device__ __forceinline__ unsigned f2bf(float f) { unsigned u = __builtin_bit_cast(unsigned, f); return (u + 0x7fffu + ((u >> 16) & 1u)) >> 16; }
__device__ __forceinline__ unsigned pk2(float lo, float hi) { return f2bf(lo) | (f2bf(hi) << 16); }
__device__ __forceinline__ float bflo(unsigned w) { return __builtin_bit_cast(float, w << 16); }
__device__ __forceinline__ float bfhi(unsigned w) { return __builtin_bit_cast(float, w & 0xffff0000u); }

#define XB_TMO      128
#define XB_XCNT(j)  (256  + 64 * (j))
#define XB_XSUB(j)  (1280 + 64 * (j))
#define XB_XGEN(j)  (2304 + 64 * (j))
#define XB_TOP      3328
#define XB_TOPGEN   3392
#define XCD_BAR_WORDS 3456
#define XB_SPIN_CAP (1u << 18)

__device__ __forceinline__ unsigned xb_ld(unsigned* p)              { return __hip_atomic_load(p, __ATOMIC_RELAXED, __HIP_MEMORY_SCOPE_AGENT); }
__device__ __forceinline__ unsigned xb_add(unsigned* p, unsigned v) { return __hip_atomic_fetch_add(p, v, __ATOMIC_RELAXED, __HIP_MEMORY_SCOPE_AGENT); }
__device__ __forceinline__ unsigned xb_xcc_id() { return (unsigned)__builtin_amdgcn_s_getreg((3 << 11) | 20) & 0xFu; }
#define XB_SPIN(cond, bar) do { unsigned _sp = 0; while (cond) { __builtin_amdgcn_s_sleep(1); \
    if ((++_sp & 255u) == 0u) { if (xb_ld(&(bar)[XB_TMO])) break; if (_sp > XB_SPIN_CAP) { atomicAdd(&(bar)[XB_TMO], 1u); break; } } } } while (0)

struct XcdBarrier {
    unsigned* bar; unsigned x;
    volatile LAS unsigned* st;
};

__device__ __forceinline__ XcdBarrier xcd_barrier_post(unsigned* bar, volatile LAS unsigned* st) {
    XcdBarrier b; b.bar = bar; b.x = xb_xcc_id(); b.st = st;
    if (threadIdx.x == 0) (void)xb_add(&bar[XB_XCNT(b.x)], 1u);
    return b;
}
__device__ __forceinline__ void xcd_barrier_complete(unsigned* bar, unsigned x, unsigned& nloc, unsigned& nx) {
    const unsigned G = gridDim.x * gridDim.y * gridDim.z;
    unsigned sum, cnt, mine, sp = 0u;
    for (;;) {
        sum = 0u; cnt = 0u; mine = 0u;
#pragma unroll
        for (unsigned j = 0; j < 16; ++j) { const unsigned c = xb_ld(&bar[XB_XCNT(j)]); sum += c; cnt += (c > 0u) ? 1u : 0u; mine = (j == x) ? c : mine; }
        if (sum == G) break;
        __builtin_amdgcn_s_sleep(1);
        if ((++sp & 255u) == 0u) { if (xb_ld(&bar[XB_TMO])) break; if (sp > XB_SPIN_CAP) { atomicAdd(&bar[XB_TMO], 1u); break; } }
    }
    nloc = mine > 0u ? mine : 1u; nx = cnt > 0u ? cnt : 1u;
}

__device__ __forceinline__ void xcd_barrier(const XcdBarrier& b) {
    asm volatile("s_waitcnt vmcnt(0)" ::: "memory");
    __syncthreads();
    if (threadIdx.x == 0) {
        unsigned* bar = b.bar;
        __builtin_amdgcn_s_waitcnt(0);
        unsigned nloc = b.st[0], nx = b.st[1];
        if (nloc == 0u) { xcd_barrier_complete(bar, b.x, nloc, nx); b.st[0] = nloc; b.st[1] = nx; }
        const unsigned old = xb_add(&bar[XB_XSUB(b.x)], 1u);
        const unsigned gen = old / nloc;
        if (old + 1u == (gen + 1u) * nloc) {
            __builtin_amdgcn_fence(__ATOMIC_RELEASE, "agent");
            asm volatile("s_waitcnt vmcnt(0)" ::: "memory");
            const unsigned og = xb_add(&bar[XB_TOP], 1u);
            const unsigned tg = og / nx;
            if (og + 1u == (tg + 1u) * nx) xb_add(&bar[XB_TOPGEN], 1u);
            else XB_SPIN(xb_ld(&bar[XB_TOPGEN]) == tg, bar);
            __builtin_amdgcn_fence(__ATOMIC_ACQUIRE, "agent");
            xb_add(&bar[XB_XGEN(b.x)], 1u);
            asm volatile("s_waitcnt vmcnt(0)" ::: "memory");
        } else {
            XB_SPIN(xb_ld(&bar[XB_XGEN(b.x)]) == gen, bar);
            __builtin_amdgcn_fence(__ATOMIC_ACQUIRE, "agent");
            asm volatile("s_waitcnt vmcnt(0)" ::: "memory");
        }
    }
    __syncthreads();
}


struct Frame {
    LAS unsigned char* lds;
    volatile LAS unsigned* MISC;
    gu32* ctl;
    int tid, lane, wave;
    int vcu, G;
    float* out; unsigned char* ws;
};
struct Args { const float* in[18]; float* out; unsigned char* ws; int ph_lo, ph_hi, use_bar, pad; };

__device__ __forceinline__ float wave_sum(float v) {
#pragma unroll
    for (int o = 1; o < 64; o <<= 1) v += __shfl_xor(v, o);
    return v;
}

__device__ __forceinline__ void p0_transpose_item(const float* W, int ld, int c0, int k0, bf16* WT, int K, int drow, const float* gk, float sc, LAS float* scr, int lane) {
#pragma unroll 8
    for (int i = 0; i < 32; ++i) { const int kk = 2 * i + (lane >> 5); scr[kk * 33 + (lane & 31)] = W[(size_t)(k0 + kk) * ld + c0 + (lane & 31)]; }
    LDS_WAIT(); asm volatile("" ::: "memory");
    const int c = lane & 7;
    float g8[8];
#pragma unroll
    for (int e = 0; e < 8; ++e) g8[e] = (gk ? gk[k0 + 8 * c + e] : 1.0f) * sc;
#pragma unroll
    for (int j = 0; j < 4; ++j) { const int n = (lane >> 3) + 8 * j; const LAS float* s = scr + (8 * c) * 33 + n;
        v4u o; o.x = pk2(s[0 * 33] * g8[0], s[1 * 33] * g8[1]); o.y = pk2(s[2 * 33] * g8[2], s[3 * 33] * g8[3]); o.z = pk2(s[4 * 33] * g8[4], s[5 * 33] * g8[5]); o.w = pk2(s[6 * 33] * g8[6], s[7 * 33] * g8[7]);
        *(GAS v4u*)(WT + (size_t)(drow + n) * K + k0 + 8 * c) = o; }
    LDS_WAIT(); asm volatile("" ::: "memory");
}
constexpr float ATT_C2 = 0.125f * 1.4426950408889634f;
__device__ __forceinline__ void p0_prologue(Frame& F, const Args& A) {
    LAS float* scr = (LAS float*)(F.lds + RING_OFF + F.wave * 16384);
    const int gw = F.vcu * NWAVES + F.wave, NGW = F.G * NWAVES;
    unsigned char* ws = F.ws;
    constexpr int I_IN = 16 * 80, I_O = 16 * 32, I_GU = 16 * 176, I_D = 44 * 32, I_QKV = 16 * 48;
    constexpr int NITEMS = I_IN + 2 * I_O + 2 * I_GU + 2 * I_D + I_QKV;
    for (int it = gw; it < NITEMS; it += NGW) {
        int r = it;
        if (r < I_IN) { const int kb = r / 80, nb = r % 80, n = 32 * nb; int c0 = n;
            if (n >= 1536) { const int t = (n - 1536) >> 8, i = (n - 1536) & 255; c0 = i < 128 ? 1536 + 128 * t + i : 2048 + 128 * t + (i - 128); }
            p0_transpose_item(A.in[3], NIN, c0, 64 * kb, (bf16*)(ws + WS_WIN), DM, n, A.in[1], 1.0f, scr, F.lane); continue; } r -= I_IN;
        if (r < I_O) { const int kb = r / 32, nb = r % 32; p0_transpose_item(A.in[9], DM, 32 * nb, 64 * kb, (bf16*)(ws + WS_WO0), DM, 32 * nb, nullptr, 1.0f, scr, F.lane); continue; } r -= I_O;
        if (r < I_O) { const int kb = r / 32, nb = r % 32; p0_transpose_item(A.in[13], DM, 32 * nb, 64 * kb, (bf16*)(ws + WS_WO1), DM, 32 * nb, nullptr, 1.0f, scr, F.lane); continue; } r -= I_O;
        if (r < 2 * I_GU) { const int L = r / I_GU; r -= L * I_GU; const int kb = r / 176, nb = r % 176, n = 32 * nb, t = n >> 8, i = n & 255;
            const float* wg_ = A.in[14]; const float* wu_ = A.in[15]; const float* src = (i < 128 ? wg_ : wu_) + (size_t)L * DM * DFF; const int c0 = 128 * t + (i & 127);
            p0_transpose_item(src, DFF, c0, 64 * kb, (bf16*)(ws + (L ? WS_WGU1 : WS_WGU0)), DM, n, A.in[2] + L * DM, 1.0f, scr, F.lane); continue; } r -= 2 * I_GU;
        if (r < 2 * I_D) { const int L = r / I_D; r -= L * I_D; const int kb = r / 32, nb = r % 32;
            p0_transpose_item(A.in[16] + (size_t)L * DFF * DM, DM, 32 * nb, 64 * kb, (bf16*)(ws + (L ? WS_WD1 : WS_WD0)), DFF, 32 * nb, nullptr, 1.0f, scr, F.lane); continue; } r -= 2 * I_D;
        { const int kb = r / 48, nb = r % 48, n = 32 * nb;
            p0_transpose_item(A.in[10], NQKV, n, 64 * kb, (bf16*)(ws + WS_WQKV), DM, n, A.in[1] + DM, n < 1024 ? ATT_C2 : 1.0f, scr, F.lane); }
    }
    { const float* wsp = A.in[6]; bf16* o = (bf16*)(ws + WS_WSP);
      for (int i = (F.vcu * 512 + F.tid) * 2; i < NGRP * CHUNK * CHUNK; i += F.G * 512 * 2) *(GAS unsigned*)(o + i) = pk2(wsp[i], wsp[i + 1]); }
    { const float* x = A.in[0]; bf16* xb = (bf16*)(ws + WS_XB); float* ssq = (float*)(ws + WS_SSQ);
      for (int m = gw; m < MTOK; m += NGW) {
          const GAS f32x4* xr = (const GAS f32x4*)(x + (size_t)m * DM) + F.lane; f32x4 v[4]; float s = 0.f;
#pragma unroll
          for (int j = 0; j < 4; ++j) { v[j] = xr[64 * j]; s += (v[j].x * v[j].x + v[j].y * v[j].y) + (v[j].z * v[j].z + v[j].w * v[j].w); }
          s = wave_sum(s);
          GAS v2u* o8 = (GAS v2u*)(xb + (size_t)m * DM) + F.lane;
#pragma unroll
          for (int j = 0; j < 4; ++j) o8[64 * j] = (v2u){pk2(v[j].x, v[j].y), pk2(v[j].z, v[j].w)};
          if (F.lane < 16) ssq[(size_t)m * 16 + F.lane] = F.lane == 0 ? s : 0.f; } }
}

constexpr int MIX_VT_STRIDE = 272;
__device__ __forceinline__ void mix_phase(Frame& F, const Args& A) {
    typedef float f32x4m __attribute__((ext_vector_type(4)));
    unsigned char* ws = F.ws;
    const bf16* U = (const bf16*)(ws + WS_U); const bf16* V = (const bf16*)(ws + WS_V); const bf16* Bb = (const bf16*)(ws + WS_BB); const bf16* Z = (const bf16*)(ws + WS_Z);
    bf16* Y = (bf16*)(ws + WS_Y); const float* vst = (const float*)(ws + WS_VST); const bf16* Wsp = (const bf16*)(ws + WS_WSP);
    const float* lng = A.in[4]; const float* lnb = A.in[5]; const float* bsp = A.in[7]; const float* cw = A.in[8];
    LAS float* s_mu = (LAS float*)(F.lds + RING_OFF); LAS float* s_rs = s_mu + 128;
    LAS unsigned char* vnT = F.lds + RING_OFF + 1024;
    const int tid = F.tid, lane = F.lane, w = F.wave, fr = lane & 15, fq = lane >> 4;
    for (int item = F.vcu; item < MTOK / CHUNK; item += F.G) {
        const int R0 = item * CHUNK;
        __syncthreads();
        if (tid < 128) { const f32x4m* p = (const f32x4m*)(vst + (size_t)(R0 + tid) * 16); float s1 = 0.f, s2 = 0.f;
#pragma unroll
            for (int k = 0; k < 4; ++k) { const f32x4m a = p[k]; s1 += a[0] + a[2]; s2 += a[1] + a[3]; }
            const float mu = s1 * (1.0f / AW), var = fmaxf(s2 * (1.0f / AW) - mu * mu, 0.f);
            s_mu[tid] = mu; s_rs[tid] = 1.0f / sqrtf(var + EPS); }
        for (int g = 0; g < NGRP; ++g) {
            __syncthreads();
            { const int c8 = tid & 15; float gg[8], bb[8];
#pragma unroll
              for (int e = 0; e < 8; ++e) { gg[e] = lng[g * 128 + c8 * 8 + e]; bb[e] = lnb[g * 128 + c8 * 8 + e]; }
#pragma unroll
              for (int j = 0; j < 4; ++j) { const int q = (tid >> 4) + 32 * j;
                  const v4u raw = *(const GAS v4u*)(V + (size_t)(R0 + q) * AW + g * 128 + c8 * 8);
                  const float mu = s_mu[q], rs = s_rs[q];
                  const unsigned wv[4] = {raw.x, raw.y, raw.z, raw.w};
#pragma unroll
                  for (int e = 0; e < 8; ++e) { const float v = (e & 1) ? bfhi(wv[e >> 1]) : bflo(wv[e >> 1]); const float vn = (v - mu) * rs * gg[e] + bb[e];
                      const int ch = c8 * 8 + e, c = ch & 31, slot = (ch & ~31) + 16 * ((c >> 2) & 1) + 4 * (c >> 3) + (c & 3);
                      *(LAS unsigned short*)(vnT + slot * MIX_VT_STRIDE + q * 2) = (unsigned short)f2bf(vn); } } }
            __syncthreads();
            f32x4m acc[8];
#pragma unroll
            for (int n = 0; n < 8; ++n) acc[n] = (f32x4m){0.f, 0.f, 0.f, 0.f};
            bf16x8 wf[4];
#pragma unroll
            for (int kk = 0; kk < 4; ++kk) wf[kk] = *(const GAS bf16x8*)(Wsp + (size_t)(g * 128 + 16 * w + fr) * 128 + 32 * kk + 8 * fq);
#pragma unroll
            for (int n = 0; n < 8; ++n)
#pragma unroll
                for (int kk = 0; kk < 4; ++kk) { const bf16x8 vf = *(const LAS bf16x8*)(vnT + (16 * n + fr) * MIX_VT_STRIDE + (32 * kk + 8 * fq) * 2);
                    acc[n] = __builtin_amdgcn_mfma_f32_16x16x32_bf16(vf, wf[kk], acc[n], 0, 0, 0); }
            const int p = 16 * w + fr; const float bs = bsp[g * 128 + p];
#pragma unroll
            for (int j = 0; j < 4; ++j) { const size_t col = (size_t)g * 128 + 32 * j + 8 * fq;
                const v4u ur = *(const GAS v4u*)(U + (size_t)(R0 + p) * AW + col);
                const f32x4m a0 = acc[2 * j] + bs, a1 = acc[2 * j + 1] + bs;
                v4u o; o.x = pk2(bflo(ur.x) * a0[0], bfhi(ur.x) * a0[1]); o.y = pk2(bflo(ur.y) * a0[2], bfhi(ur.y) * a0[3]);
                o.z = pk2(bflo(ur.z) * a1[0], bfhi(ur.z) * a1[1]); o.w = pk2(bflo(ur.w) * a1[2], bfhi(ur.w) * a1[3]);
                *(GAS v4u*)(Y + (size_t)(R0 + p) * DM + col) = o; }
        }
        { const int c8 = tid & 63, rg = tid >> 6; float w0[8], w1[8], w2[8];
#pragma unroll
          for (int e = 0; e < 8; ++e) { w0[e] = cw[c8 * 8 + e]; w1[e] = cw[BW + c8 * 8 + e]; w2[e] = cw[2 * BW + c8 * 8 + e]; }
          const int rfirst = R0 + 16 * rg; const v4u zero = (v4u){0u, 0u, 0u, 0u};
          v4u zp = (rfirst & (SEQ - 1)) ? *(const GAS v4u*)(Z + (size_t)(rfirst - 1) * BW + c8 * 8) : zero;
          v4u zc = *(const GAS v4u*)(Z + (size_t)rfirst * BW + c8 * 8);
          for (int rr = 0; rr < 16; ++rr) { const int row = rfirst + rr;
              const v4u zn = ((row + 1) & (SEQ - 1)) ? *(const GAS v4u*)(Z + (size_t)(row + 1) * BW + c8 * 8) : zero;
              const v4u bv = *(const GAS v4u*)(Bb + (size_t)row * BW + c8 * 8);
              const unsigned zpw[4] = {zp.x, zp.y, zp.z, zp.w}, zcw[4] = {zc.x, zc.y, zc.z, zc.w}, znw[4] = {zn.x, zn.y, zn.z, zn.w}, bw[4] = {bv.x, bv.y, bv.z, bv.w};
              unsigned ow[4];
#pragma unroll
              for (int k = 0; k < 4; ++k) {
                  const float lo = bflo(bw[k]) * (bflo(zpw[k]) * w0[2 * k] + bflo(zcw[k]) * w1[2 * k] + bflo(znw[k]) * w2[2 * k]);
                  const float hi = bfhi(bw[k]) * (bfhi(zpw[k]) * w0[2 * k + 1] + bfhi(zcw[k]) * w1[2 * k + 1] + bfhi(znw[k]) * w2[2 * k + 1]);
                  ow[k] = pk2(lo, hi); }
              *(GAS v4u*)(Y + (size_t)row * DM + AW + c8 * 8) = (v4u){ow[0], ow[1], ow[2], ow[3]};
              zp = zc; zc = zn; } }
    }
    __syncthreads();
}

__device__ __forceinline__ void fin_phase(Frame& F, const Args& A) {
    const int gw = F.vcu * NWAVES + F.wave, NGW = F.G * NWAVES; const float* ssq = (const float*)(F.ws + WS_SSQ); const float* g = A.in[17];
    f32x4 gg[4];
#pragma unroll
    for (int j = 0; j < 4; ++j) gg[j] = ((const GAS f32x4*)g)[F.lane + 64 * j];
    for (int m = gw; m < MTOK; m += NGW) {
        const float rs = pg8::row_rstd(ssq, m);
        GAS f32x4* xr = (GAS f32x4*)(F.out + (size_t)m * DM) + F.lane;
#pragma unroll
        for (int j = 0; j < 4; ++j) { const f32x4 v = xr[64 * j]; xr[64 * j] = v * rs * gg[j]; }
    }
}

__global__ void __launch_bounds__(NWAVES * 64, 2) mk_fwd(Args args) {
    extern __shared__ __attribute__((aligned(16))) unsigned char lds[];
    Frame F;
    F.lds = (LAS unsigned char*)lds;
    F.MISC = (volatile LAS unsigned*)(F.lds + MISC_OFF);
    F.tid = threadIdx.x; F.lane = F.tid & 63; F.wave = __builtin_amdgcn_readfirstlane(F.tid >> 6);
    F.G = gridDim.x; { const int bx = blockIdx.x; F.vcu = (F.G % 8 == 0) ? (bx % 8) * (F.G / 8) + bx / 8 : bx; }
    F.out = args.out; F.ws = args.ws;
    unsigned char* ws = args.ws;
    F.ctl = (gu32*)(ws + WS_CTL);
    for (int u = F.tid; u < (LDS_BYTES - MISC_OFF) / 4; u += NWAVES * 64) ((LAS unsigned*)(F.lds + MISC_OFF))[u] = 0u;
    __syncthreads();
    XcdBarrier bar; bar.bar = (unsigned*)(F.ctl + CW_BAR); bar.x = 0; bar.st = nullptr;
    if (args.use_bar) bar = xcd_barrier_post((unsigned*)(F.ctl + CW_BAR), F.MISC + 8);
    const int lo = args.ph_lo, hi = args.ph_hi;
#ifndef MK_PHASE_MASK
#define MK_PHASE_MASK 0xFFF
#endif
#define IN(k) (((MK_PHASE_MASK >> (k)) & 1) && lo <= (k) && (k) < hi)
#define SEAM(k) do { if (IN(k) && IN((k) + 1)) { if (args.use_bar) xcd_barrier(bar); else { if (F.tid == 0) __hip_atomic_store(F.ctl + CW_TMO, 0xBADBA0u | (unsigned)(k), RLX_AGENT); } } } while (0)
    LAS float* rtab = (LAS float*)(F.lds + RSTD_OFF);
    const float* ssq = (const float*)(ws + WS_SSQ); float* ssqw = (float*)(ws + WS_SSQ);
    pg8::bf16_t* XB = (pg8::bf16_t*)(ws + WS_XB);

    if (IN(0)) { p0_prologue(F, args); } SEAM(0);
    if (IN(1)) {
        pg8::Gemm g{XB, (const pg8::bf16_t*)(ws + WS_WIN), MTOK, NIN, DM}; pg8::StaticOrder S; S.init(MTOK, NIN, F.G, (int)blockIdx.x);
        pg8::EpiMix1 E{pg8::fill_rstd_tab(rtab, ssq, S), (pg8::bf16_t*)(ws + WS_U), (float*)(ws + WS_VST)};
        pg8::gemm_phase<pg8::EpiMix1, pg8::StaticOrder, true, true>(F.lds + RING_OFF, g, S, E);
    } SEAM(1);
    if (IN(2)) { mix_phase(F, args); } SEAM(2);
    if (IN(3)) {
        pg8::Gemm g{(const pg8::bf16_t*)(ws + WS_Y), (const pg8::bf16_t*)(ws + WS_WO0), MTOK, DM, DM}; pg8::StaticOrder S; S.init(MTOK, DM, F.G, (int)blockIdx.x);
        pg8::EpiRes E{args.in[0], F.out, XB, ssqw};
        pg8::gemm_phase<pg8::EpiRes, pg8::StaticOrder, true, true>(F.lds + RING_OFF, g, S, E);
    } SEAM(3);
#define FFN_UP(pu, WGU) if (IN(pu)) {     \
        pg8::Gemm g{XB, (const pg8::bf16_t*)(ws + (WGU)), MTOK, 2 * DFF, DM}; pg8::StaticOrder S; S.init(MTOK, 2 * DFF, F.G, (int)blockIdx.x); \
        pg8::EpiSwiglu E{pg8::fill_rstd_tab(rtab, ssq, S), (pg8::bf16_t*)(ws + WS_ACT)}; \
        pg8::gemm_phase<pg8::EpiSwiglu, pg8::StaticOrder, true, true>(F.lds + RING_OFF, g, S, E); } SEAM(pu)
#define FFN_DOWN(pd, WD) if (IN(pd)) {     \
        pg8::Gemm g{(const pg8::bf16_t*)(ws + WS_ACT), (const pg8::bf16_t*)(ws + (WD)), MTOK, DM, DFF}; pg8::StaticOrder S; S.init(MTOK, DM, F.G, (int)blockIdx.x); \
        pg8::EpiRes E{F.out, F.out, XB, ssqw}; \
        pg8::gemm_phase<pg8::EpiRes, pg8::StaticOrder, true, true>(F.lds + RING_OFF, g, S, E); } SEAM(pd)
    FFN_UP(4, WS_WGU0);
    FFN_DOWN(5, WS_WD0);
    if (IN(6)) {
        pg8::Gemm g{XB, (const pg8::bf16_t*)(ws + WS_WQKV), MTOK, NQKV, DM}; pg8::StaticOrder S; S.init(MTOK, NQKV, F.G, (int)blockIdx.x);
        pg8::EpiQKV E{pg8::fill_rstd_tab(rtab, ssq, S), (pg8::bf16_t*)(ws + WS_Q)};
        pg8::gemm_phase<pg8::EpiQKV, pg8::StaticOrder, true, true>(F.lds + RING_OFF, g, S, E);
    } SEAM(6);
    if (IN(7)) { att::att_phase(F.lds + RING_OFF, (const att::bf16_t*)(ws + WS_Q), (const att::bf16_t*)(ws + WS_K), (const att::bf16_t*)(ws + WS_VV), (att::bf16_t*)(ws + WS_O), args.in[11], args.in[12], F.vcu, F.G); } SEAM(7);
    if (IN(8)) {
        pg8::Gemm g{(const pg8::bf16_t*)(ws + WS_O), (const pg8::bf16_t*)(ws + WS_WO1), MTOK, DM, DM}; pg8::StaticOrder S; S.init(MTOK, DM, F.G, (int)blockIdx.x);
        pg8::EpiRes E{F.out, F.out, XB, ssqw};
        pg8::gemm_phase<pg8::EpiRes, pg8::StaticOrder, true, true>(F.lds + RING_OFF, g, S, E);
    } SEAM(8);
    FFN_UP(9, WS_WGU1);
    FFN_DOWN(10, WS_WD1);
#undef FFN_UP
#undef FFN_DOWN
    if (IN(11)) { fin_phase(F, args); }
#undef IN
#undef SEAM
}

namespace simple {

__device__ __forceinline__ float wave_sum(float v) {
#pragma unroll
    for (int o = 1; o < 64; o <<= 1) v += __shfl_xor(v, o);
    return v;
}
__device__ __forceinline__ float wave_max(float v) {
#pragma unroll
    for (int o = 1; o < 64; o <<= 1) v = fmaxf(v, __shfl_xor(v, o));
    return v;
}

__global__ void __launch_bounds__(256) rmsnorm_rows(const float* x, const float* g, float* out, int rows) {
    const int lane = threadIdx.x & 63, w = (blockIdx.x * blockDim.x + threadIdx.x) >> 6;
    if (w >= rows) return;
    const float4* xr = (const float4*)(x + (size_t)w * DM);
    float4 v[4]; float s = 0.f;
#pragma unroll
    for (int j = 0; j < 4; ++j) { v[j] = xr[lane + 64 * j]; s += v[j].x * v[j].x + v[j].y * v[j].y + v[j].z * v[j].z + v[j].w * v[j].w; }
    s = wave_sum(s);
    const float r = 1.0f / sqrtf(s * (1.0f / DM) + EPS);
    float4* orow = (float4*)(out + (size_t)w * DM);
#pragma unroll
    for (int j = 0; j < 4; ++j) { const float4 gg = ((const float4*)g)[lane + 64 * j]; float4 o; o.x = v[j].x * r * gg.x; o.y = v[j].y * r * gg.y; o.z = v[j].z * r * gg.z; o.w = v[j].w * r * gg.w; orow[lane + 64 * j] = o; }
}

template <int ACCUM>
__global__ void __launch_bounds__(256) sgemm(const float* __restrict__ A, const float* __restrict__ B, float* C, int M, int N, int K) {
    __shared__ float As[16][132];
    __shared__ float Bs[16][132];
    const int tid = threadIdx.x, tx = tid & 15, ty = tid >> 4;
    const int m0 = blockIdx.y * 128, n0 = blockIdx.x * 128;
    float acc[8][8];
#pragma unroll
    for (int i = 0; i < 8; ++i)
#pragma unroll
        for (int j = 0; j < 8; ++j) acc[i][j] = 0.f;
    const int ar = tid >> 2, ac = (tid & 3) * 4;
    const int br = tid >> 5, bc = (tid & 31) * 4;
    for (int k0 = 0; k0 < K; k0 += 16) {
        const float4 a0 = *(const float4*)(A + (size_t)(m0 + ar) * K + k0 + ac);
        const float4 a1 = *(const float4*)(A + (size_t)(m0 + ar + 64) * K + k0 + ac);
        const float4 b0 = *(const float4*)(B + (size_t)(k0 + br) * N + n0 + bc);
        const float4 b1 = *(const float4*)(B + (size_t)(k0 + br + 8) * N + n0 + bc);
        __syncthreads();
        As[ac + 0][ar] = a0.x; As[ac + 1][ar] = a0.y; As[ac + 2][ar] = a0.z; As[ac + 3][ar] = a0.w;
        As[ac + 0][ar + 64] = a1.x; As[ac + 1][ar + 64] = a1.y; As[ac + 2][ar + 64] = a1.z; As[ac + 3][ar + 64] = a1.w;
        *(float4*)&Bs[br][bc] = b0; *(float4*)&Bs[br + 8][bc] = b1;
        __syncthreads();
#pragma unroll
        for (int k = 0; k < 16; ++k) {
            const float4 x0 = *(const float4*)&As[k][ty * 4], x1 = *(const float4*)&As[k][64 + ty * 4];
            const float4 y0 = *(const float4*)&Bs[k][tx * 4], y1 = *(const float4*)&Bs[k][64 + tx * 4];
            const float a[8] = {x0.x, x0.y, x0.z, x0.w, x1.x, x1.y, x1.z, x1.w};
            const float b[8] = {y0.x, y0.y, y0.z, y0.w, y1.x, y1.y, y1.z, y1.w};
#pragma unroll
            for (int i = 0; i < 8; ++i)
#pragma unroll
                for (int j = 0; j < 8; ++j) acc[i][j] = fmaf(a[i], b[j], acc[i][j]);
        }
    }
#pragma unroll
    for (int i = 0; i < 8; ++i) {
        const int r = m0 + (i < 4 ? ty * 4 + i : 64 + ty * 4 + (i - 4));
#pragma unroll
        for (int jh = 0; jh < 2; ++jh) {
            float* p = C + (size_t)r * N + n0 + jh * 64 + tx * 4;
            float4 o; o.x = acc[i][jh * 4 + 0]; o.y = acc[i][jh * 4 + 1]; o.z = acc[i][jh * 4 + 2]; o.w = acc[i][jh * 4 + 3];
            if (ACCUM) { const float4 c = *(const float4*)p; o.x += c.x; o.y += c.y; o.z += c.z; o.w += c.w; }
            *(float4*)p = o;
        }
    }
}

__device__ __forceinline__ float gelu_exact(float v) { return 0.5f * v * (1.0f + erff(v * 0.70710678118654752f)); }

__global__ void __launch_bounds__(256) mixer_vn(const float* P, const float* g, const float* bta, float* VN, int rows) {
    const int lane = threadIdx.x & 63, w = (blockIdx.x * blockDim.x + threadIdx.x) >> 6;
    if (w >= rows) return;
    const float* pr = P + (size_t)w * NIN + AW;
    float v[8]; float s = 0.f;
#pragma unroll
    for (int j = 0; j < 8; ++j) { v[j] = gelu_exact(pr[lane + 64 * j]); s += v[j]; }
    const float mu = wave_sum(s) * (1.0f / AW);
    float q = 0.f;
#pragma unroll
    for (int j = 0; j < 8; ++j) { v[j] -= mu; q += v[j] * v[j]; }
    const float rs = 1.0f / sqrtf(wave_sum(q) * (1.0f / AW) + EPS);
#pragma unroll
    for (int j = 0; j < 8; ++j) VN[(size_t)w * AW + lane + 64 * j] = v[j] * rs * g[lane + 64 * j] + bta[lane + 64 * j];
}

__global__ void __launch_bounds__(256) mixer_out(const float* P, const float* VN, const float* Wsp, const float* bsp, const float* cw, float* Y, int rows) {
    const int idx = blockIdx.x * blockDim.x + threadIdx.x;
    if (idx >= rows * DM) return;
    const int r = idx >> 10, c = idx & 1023;
    if (c < AW) {
        const int g = c >> 7, p = r & 127, r0 = r & ~127;
        const float* wrow = Wsp + ((size_t)g * CHUNK + p) * CHUNK;
        float s = 0.f;
        for (int q = 0; q < CHUNK; ++q) s = fmaf(wrow[q], VN[(size_t)(r0 + q) * AW + c], s);
        s += bsp[g * CHUNK + p];
        Y[(size_t)r * DM + c] = gelu_exact(P[(size_t)r * NIN + c]) * s;
    } else {
        const int cc = c - AW;
        const float* pr = P + (size_t)r * NIN;
        float conv = pr[1536 + cc] * pr[2048 + cc] * cw[BW + cc];
        if (r > 0) conv += pr[1536 + cc - NIN] * pr[2048 + cc - NIN] * cw[cc];
        if (r < rows - 1) conv += pr[1536 + cc + NIN] * pr[2048 + cc + NIN] * cw[2 * BW + cc];
        Y[(size_t)r * DM + c] = pr[1024 + cc] * conv;
    }
}

__global__ void __launch_bounds__(256) swiglu_act(float* G, const float* U, int n) {
    const int i = blockIdx.x * blockDim.x + threadIdx.x;
    if (i >= n) return;
    const float g = G[i];
    G[i] = g / (1.0f + expf(-g)) * U[i];
}

__device__ __forceinline__ int t5_bucket(int rel) {
    const int n = rel < 0 ? -rel : rel;
    int b;
    if (n < 8) b = n;
    else { const int n2 = n * n; const int lg = 31 - __clz(n2); b = 8 + (lg - 6); if (b > 15) b = 15; }
    return (rel > 0 ? 16 : 0) + b;
}

__global__ void __launch_bounds__(256) attn_naive(const float* QKV, const float* sink, const float* relb, float* O, int rows) {
    __shared__ float pbuf[4][320];
    __shared__ float qbuf[4][64];
    const int lane = threadIdx.x & 63, wl = threadIdx.x >> 6, w = (blockIdx.x * blockDim.x + threadIdx.x) >> 6;
    if (w >= rows * NH) return;
    const int s = w / NH, h = w % NH, kvh = h / 4;
    qbuf[wl][lane] = QKV[(size_t)s * NQKV + h * HD + lane];
    __builtin_amdgcn_s_waitcnt(0);
    const int j0 = s - WIN;
    float sc[5]; float mx = -INFINITY;
#pragma unroll
    for (int t = 0; t < 5; ++t) {
        const int jj = lane + 64 * t, j = j0 + jj;
        sc[t] = -INFINITY;
        if (jj <= 2 * WIN && j >= 0 && j < rows) {
            const float* kr = QKV + (size_t)j * NQKV + NH * HD + kvh * HD;
            float d = 0.f;
            for (int e = 0; e < HD; ++e) d = fmaf(qbuf[wl][e], kr[e], d);
            sc[t] = d * 0.125f + relb[t5_bucket(j - s) * NH + h];
            mx = fmaxf(mx, sc[t]);
        }
    }
    const float sk = sink[h];
    const float m = fmaxf(wave_max(mx), sk);
    float psum = 0.f;
#pragma unroll
    for (int t = 0; t < 5; ++t) { const float p = (sc[t] == -INFINITY) ? 0.f : expf(sc[t] - m); pbuf[wl][lane + 64 * t] = p; psum += p; }
    const float denom = wave_sum(psum) + expf(sk - m);
    __builtin_amdgcn_s_waitcnt(0);
    float o = 0.f;
    for (int jj = 0; jj <= 2 * WIN; ++jj) {
        const int j = j0 + jj;
        if (j < 0 || j >= rows) continue;
        o = fmaf(pbuf[wl][jj], QKV[(size_t)j * NQKV + (NH + NKV) * HD + kvh * HD + lane], o);
    }
    O[(size_t)s * DM + h * HD + lane] = o / denom;
}

}


#ifndef MK_OPT_PHASES
#define MK_OPT_PHASES 12
#endif
#ifndef MK_ONE_LAUNCH
#define MK_ONE_LAUNCH 1
#endif
constexpr size_t OR_BASE = 320 * MiB;
constexpr size_t OR_H = OR_BASE, OR_P = OR_H + 16 * MiB, OR_Y = OR_P + 88 * MiB, OR_VN = OR_Y + 16 * MiB, OR_END = OR_VN + 8 * MiB;

namespace simple {
__global__ void __launch_bounds__(256) cvt_bf16_f32(const unsigned short* src, float* dst, int rows, int cols, int sld, int dld, float scale) {
    const int idx = blockIdx.x * blockDim.x + threadIdx.x; if (idx >= rows * cols) return;
    const int r = idx / cols, c = idx - r * cols;
    dst[(size_t)r * dld + c] = __builtin_bit_cast(float, (unsigned)src[(size_t)r * sld + c] << 16) * scale;
}
}
static void simple_gemm(hipStream_t st, const float* A, const float* B, float* C, int M, int N, int K, bool accum) {
    dim3 grid(N / 128, M / 128);
    if (accum) hipLaunchKernelGGL(simple::sgemm<1>, grid, dim3(256), 0, st, A, B, C, M, N, K);
    else hipLaunchKernelGGL(simple::sgemm<0>, grid, dim3(256), 0, st, A, B, C, M, N, K);
}
static void simple_cvt(hipStream_t st, const void* src, float* dst, int rows, int cols, int sld, int dld, float scale) {
    hipLaunchKernelGGL(simple::cvt_bf16_f32, dim3((rows * cols + 255) / 256), dim3(256), 0, st, (const unsigned short*)src, dst, rows, cols, sld, dld, scale);
}

extern "C" void kernel_launch(void* const* d_in, const int* in_sizes, int n_in, void* d_out, int out_size, void* d_ws, size_t ws_size, hipStream_t stream) {
    constexpr int KOPT = MK_OPT_PHASES;
    static int grid = 0;
    if (grid == 0) {
        if (n_in != 18 || in_sizes[0] != MTOK * DM || out_size != MTOK * DM || ws_size < OR_END) { fprintf(stderr, "kernel_launch: unexpected shapes / workspace (%d inputs, out %d, ws %zu)\n", n_in, out_size, ws_size); grid = -1; return; }
        int dev = 0, cus = 0, per_cu = 0;
        if (hipGetDevice(&dev) != hipSuccess || hipDeviceGetAttribute(&cus, hipDeviceAttributeMultiprocessorCount, dev) != hipSuccess) { grid = -1; return; }
        if (hipFuncSetAttribute((const void*)mk_fwd, hipFuncAttributeMaxDynamicSharedMemorySize, LDS_BYTES) != hipSuccess) { fprintf(stderr, "kernel_launch: hipFuncSetAttribute failed\n"); grid = -1; return; }
        if (hipOccupancyMaxActiveBlocksPerMultiprocessor(&per_cu, (const void*)mk_fwd, NWAVES * 64, LDS_BYTES) != hipSuccess || per_cu < 1) { fprintf(stderr, "kernel_launch: occupancy query says %d blocks per CU\n", per_cu); (void)hipGetLastError(); grid = -1; return; }
        if (cus != 256) { fprintf(stderr, "kernel_launch: built for a 256-CU device, found %d\n", cus); grid = -1; return; }
        grid = cus;
    }
    if (grid < 0) return;
    const float* const* in = (const float* const*)d_in;
    float* out = (float*)d_out; unsigned char* ws = (unsigned char*)d_ws;
    if (KOPT > 0) {
        (void)hipMemsetAsync(ws + WS_CTL, 0, CTL_ZERO_BYTES, stream);
        Args a{};
        for (int i = 0; i < 18; ++i) a.in[i] = in[i];
        a.out = out; a.ws = ws;
        if (KOPT == N_PHASES && MK_ONE_LAUNCH) { a.ph_lo = 0; a.ph_hi = N_PHASES; a.use_bar = 1; hipLaunchKernelGGL(mk_fwd, dim3(grid), dim3(NWAVES * 64), LDS_BYTES, stream, a); }
        else for (int p = 0; p < KOPT; ++p) { a.ph_lo = p; a.ph_hi = p + 1; a.use_bar = 0; hipLaunchKernelGGL(mk_fwd, dim3(grid), dim3(NWAVES * 64), LDS_BYTES, stream, a); }
    }
    if (KOPT >= N_PHASES) return;
    const float* x = in[0]; const float* norm_mix = in[1]; const float* norm_ffn = in[2]; const float* w_in = in[3]; const float* vln_g = in[4]; const float* vln_b = in[5];
    const float* w_sp = in[6]; const float* b_sp = in[7]; const float* conv_w = in[8]; const float* w_out0 = in[9]; const float* w_qkv = in[10]; const float* sink = in[11];
    const float* relb = in[12]; const float* w_out1 = in[13]; const float* w_gate = in[14]; const float* w_up = in[15]; const float* w_down = in[16]; const float* fin = in[17];
    float* H = (float*)(ws + OR_H); float* P = (float*)(ws + OR_P); float* Y = (float*)(ws + OR_Y); float* VN = (float*)(ws + OR_VN);
    float* P2 = P + (size_t)SEQ * DFF;
    const int s0 = KOPT < 3 ? 0 : KOPT - 2;
    if (KOPT < 4) (void)hipMemcpyAsync(out, x, (size_t)MTOK * DM * sizeof(float), hipMemcpyDeviceToDevice, stream);
    const int rows = SEQ, rb = rows * 64 / 256;
    for (int b = 0; b < BATCH; ++b) {
        float* xr = out + (size_t)b * SEQ * DM; const size_t r0 = (size_t)b * SEQ;
        if (s0 <= 0) {
            hipLaunchKernelGGL(simple::rmsnorm_rows, dim3(rb), dim3(256), 0, stream, (const float*)xr, norm_mix, H, rows);
            simple_gemm(stream, H, w_in, P, rows, NIN, DM, false);
            hipLaunchKernelGGL(simple::mixer_vn, dim3(rb), dim3(256), 0, stream, (const float*)P, vln_g, vln_b, VN, rows);
            hipLaunchKernelGGL(simple::mixer_out, dim3(rows * DM / 256), dim3(256), 0, stream, (const float*)P, (const float*)VN, w_sp, b_sp, conv_w, Y, rows);
        }
        if (s0 == 1) simple_cvt(stream, ws + WS_Y + r0 * DM * 2, Y, rows, DM, DM, DM, 1.0f);
        if (s0 <= 1) simple_gemm(stream, Y, w_out0, xr, rows, DM, DM, true);
        if (s0 <= 2) {
            hipLaunchKernelGGL(simple::rmsnorm_rows, dim3(rb), dim3(256), 0, stream, (const float*)xr, norm_ffn, H, rows);
            simple_gemm(stream, H, w_gate, P, rows, DFF, DM, false);
            simple_gemm(stream, H, w_up, P2, rows, DFF, DM, false);
            hipLaunchKernelGGL(simple::swiglu_act, dim3(rows * DFF / 256), dim3(256), 0, stream, P, (const float*)P2, rows * DFF);
        }
        if (s0 == 3) simple_cvt(stream, ws + WS_ACT + r0 * DFF * 2, P, rows, DFF, DFF, DFF, 1.0f);
        if (s0 <= 3) simple_gemm(stream, P, w_down, xr, rows, DM, DFF, true);
        if (s0 <= 4) {
            hipLaunchKernelGGL(simple::rmsnorm_rows, dim3(rb), dim3(256), 0, stream, (const float*)xr, norm_mix + DM, H, rows);
            simple_gemm(stream, H, w_qkv, P, rows, NQKV, DM, false);
        }
        if (s0 == 5) { simple_cvt(stream, ws + WS_Q + r0 * DM * 2, P, rows, DM, DM, NQKV, 1.0f / ATT_C2);
                       simple_cvt(stream, ws + WS_K + r0 * 256 * 2, P + 1024, rows, 256, 256, NQKV, 1.0f);
                       simple_cvt(stream, ws + WS_VV + r0 * 256 * 2, P + 1280, rows, 256, 256, NQKV, 1.0f); }
        if (s0 <= 5) hipLaunchKernelGGL(simple::attn_naive, dim3(rows * NH / 4), dim3(256), 0, stream, (const float*)P, sink, relb, Y, rows);
        if (s0 == 6) simple_cvt(stream, ws + WS_O + r0 * DM * 2, Y, rows, DM, DM, DM, 1.0f);
        if (s0 <= 6) simple_gemm(stream, Y, w_out1, xr, rows, DM, DM, true);
        if (s0 <= 7) {
            hipLaunchKernelGGL(simple::rmsnorm_rows, dim3(rb), dim3(256), 0, stream, (const float*)xr, norm_ffn + DM, H, rows);
            simple_gemm(stream, H, w_gate + (size_t)DM * DFF, P, rows, DFF, DM, false);
            simple_gemm(stream, H, w_up + (size_t)DM * DFF, P2, rows, DFF, DM, false);
            hipLaunchKernelGGL(simple::swiglu_act, dim3(rows * DFF / 256), dim3(256), 0, stream, P, (const float*)P2, rows * DFF);
        }
        if (s0 == 8) simple_cvt(stream, ws + WS_ACT + r0 * DFF * 2, P, rows, DFF, DFF, DFF, 1.0f);
        if (s0 <= 8) simple_gemm(stream, P, w_down + (size_t)DFF * DM, xr, rows, DM, DFF, true);
        hipLaunchKernelGGL(simple::rmsnorm_rows, dim3(rb), dim3(256), 0, stream, (const float*)xr, fin, xr, rows);
    }
}
```

```cpp
#define MK_OPT_PHASES 12
#define MK_ONE_LAUNCH 1

#include <hip/hip_runtime.h>
#include <cstdio>
#include <cstdint>
#include <cmath>

constexpr int BATCH = 8, SEQ = 4096, DM = 1024, MTOK = BATCH * SEQ;
constexpr int AW = 512, BW = 512, NIN = 2560, CHUNK = 128, NGRP = 4;
constexpr int NH = 16, NKV = 4, HD = 64, NQKV = 1536, WIN = 128;
constexpr int DFF = 2816;
constexpr float EPS = 1e-6f;
constexpr size_t MiB = 1u << 20;
namespace pg8 {
#define PG8_LAS __attribute__((address_space(3)))
typedef unsigned short bf16_t;
typedef short bf16x8 __attribute__((ext_vector_type(8)));
typedef float f32x4 __attribute__((ext_vector_type(4)));
typedef unsigned u32x4 __attribute__((ext_vector_type(4)));
constexpr int BM = 256, BK = 64, HALF = 128, HTB = HALF * BK * 2  , STAGE_BYTES = 8 * HTB, NXCD = 8, WGM = 8;

__host__ __device__ __forceinline__ int lds_byte(int r, int c) { const int st = (r >> 4) * 2 + (c >> 5), rr = r & 15, cc = c & 31, ob = rr * 64 + cc * 2; return st * 1024 + (ob ^ (((ob >> 9) & 1) << 5)); }
__host__ __device__ __forceinline__ void stage_rc(int b, int& R, int& C) { const int st = b / 1024, sb = b % 1024, swz = sb ^ (((sb >> 9) & 1) << 5); R = (st >> 1) * 16 + swz / 64; C = (st & 1) * 32 + (swz % 64) / 2; }
__host__ __device__ __forceinline__ int perm32(int rho) { const int n = rho >> 4, i = rho & 15; return 8 * (i >> 2) + 4 * n + (i & 3); }

struct Unit { int pm, pn; };
struct Gemm { const bf16_t* A; const bf16_t* Bt; int M, N, K; };

struct StaticOrder {
    int nM, nN, nwg, G, c;
    __host__ __device__ void init(int M, int N, int G_, int c_) { nM = M / BM; nN = N / BM; nwg = nM * nN; G = G_; c = c_; }
    __host__ __device__ bool next(int i, Unit& u) const {
        const long L = (long)i * G + c; if (L >= nwg) return false;
        int wgid = (int)L; { const int q = nwg / NXCD, r = nwg % NXCD, xcd = wgid % NXCD, off = wgid / NXCD; wgid = (xcd < r ? xcd * (q + 1) : r * (q + 1) + (xcd - r) * q) + off; }
        const int nig = WGM * nN, gid = wgid / nig, fm = gid * WGM, gsz = (nM - fm) < WGM ? (nM - fm) : WGM;
        u.pm = fm + ((wgid % nig) % gsz); u.pn = (wgid % nig) / gsz; return true;
    }
    __device__ __forceinline__ void a_ready(const Unit&) const {}
    __device__ __forceinline__ void done(const Unit&) const {}
};


__device__ __forceinline__ unsigned cvt_pk_bf16(float lo, float hi) { unsigned r; asm volatile("v_cvt_pk_bf16_f32 %0, %1, %2" : "=v"(r) : "v"(lo), "v"(hi)); return r; }
typedef float f32x2 __attribute__((ext_vector_type(2)));
typedef unsigned u32x2 __attribute__((ext_vector_type(2)));
__device__ __forceinline__ f32x2 gelu_pk(f32x2 v) {
    const f32x2 av = __builtin_elementwise_abs(v), d = av * 0.2316418882f + 1.0f;
    f32x2 t; t.x = __builtin_amdgcn_rcpf(d.x); t.y = __builtin_amdgcn_rcpf(d.y);
    f32x2 q = t * 0.5307027145f + (-0.7265760135f); q = q * t + 0.7107068705f; q = q * t + (-0.142248368f); q = q * t + 0.127414796f; q = q * t;
    const f32x2 s = (v * v) * (-0.72134752044f);
    f32x2 e; e.x = __builtin_amdgcn_exp2f(s.x); e.y = __builtin_amdgcn_exp2f(s.y);
    const f32x2 m = v * (q * e), r = v - m;
    f32x2 o; o.x = v.x < 0.f ? m.x : r.x; o.y = v.y < 0.f ? m.y : r.y; return o;
}
__device__ __forceinline__ f32x4 gelu4(f32x4 v) { const f32x2 a = gelu_pk((f32x2){v[0], v[1]}), b = gelu_pk((f32x2){v[2], v[3]}); return (f32x4){a.x, a.y, b.x, b.y}; }
__device__ __forceinline__ float silu1(float g) { return g * __builtin_amdgcn_rcpf(1.0f + __builtin_amdgcn_exp2f(g * -1.4426950408889634f)); }
constexpr float RMS_EPS = 1e-6f;
constexpr int SSQ_SLOTS = 16;
__device__ __forceinline__ float row_rstd(const float* ssq, int r) {
    const f32x4* p = (const f32x4*)(ssq + (size_t)r * SSQ_SLOTS);
    const f32x4 a = p[0], b = p[1], c = p[2], d = p[3];
    const float s = ((a[0] + a[1]) + (a[2] + a[3])) + ((b[0] + b[1]) + (b[2] + b[3])) + ((c[0] + c[1]) + (c[2] + c[3])) + ((d[0] + d[1]) + (d[2] + d[3]));
    return 1.0f / sqrtf(s * (1.0f / 1024.0f) + RMS_EPS);
}
struct RstdTab {
    const PG8_LAS float* tab; int pmA;
    __device__ __forceinline__ float get(int pm, int rl) const { return tab[(pm != pmA ? 256 : 0) + rl]; }
};
template <class Sched> __device__ __forceinline__ RstdTab fill_rstd_tab(PG8_LAS float* tab, const float* ssq, const Sched& S) {
    Unit u0, u1, t; int pmA = 0, pmB = 0;
    if (S.next(0, u0)) { pmA = u0.pm; pmB = u0.pm; for (int i = 1; S.next(i, t); ++i) pmB = t.pm; }
    const int tid = threadIdx.x, pm = tid < 256 ? pmA : pmB;
    tab[tid] = row_rstd(ssq, pm * BM + (tid & 255));
    __syncthreads();
    RstdTab T; T.tab = tab; T.pmA = pmA; return T;
}
__device__ __forceinline__ u32x4 pack8(f32x4 a, f32x4 b) { u32x4 w; w.x = cvt_pk_bf16(a[0], a[1]); w.y = cvt_pk_bf16(a[2], a[3]); w.z = cvt_pk_bf16(b[0], b[1]); w.w = cvt_pk_bf16(b[2], b[3]); return w; }

struct EpiMix1 {
    static constexpr bool PERM = true, AFTER_DRAIN = false;
    RstdTab T; bf16_t* U4; float* vst;
    __device__ __forceinline__ void init(f32x4 (&acc)[2][2][4][2], const Unit&, int, int, int, int) const {
#pragma unroll
        for (int a = 0; a < 2; ++a)
#pragma unroll
            for (int b = 0; b < 2; ++b)
#pragma unroll
                for (int m = 0; m < 4; ++m)
#pragma unroll
                    for (int n = 0; n < 2; ++n) acc[a][b][m][n] = (f32x4){0.f, 0.f, 0.f, 0.f};
    }
    __device__ __forceinline__ void operator()(const f32x4 (&acc)[2][2][4][2], const Unit& u, int wr, int wc, int fr, int fq) const {
        const int row0 = u.pm * BM + wr * 64 + fr, pn = u.pn, cl = wc * 32 + 8 * fq;
        float rs[2][4];
#pragma unroll
        for (int ai = 0; ai < 2; ++ai)
#pragma unroll
            for (int m = 0; m < 4; ++m) rs[ai][m] = T.get(u.pm, wr * 64 + fr + ai * HALF + m * 16);
        if (pn < 6) {
            bf16_t* base = U4 + (size_t)(pn >> 1) * ((size_t)32768 * 512); const int colt = (pn & 1) * 256 + cl;
#pragma unroll
            for (int ai = 0; ai < 2; ++ai)
#pragma unroll
                for (int m = 0; m < 4; ++m) { const int r = row0 + ai * HALF + m * 16; const float s = rs[ai][m]; float s1 = 0.f, s2 = 0.f;
#pragma unroll
                    for (int bj = 0; bj < 2; ++bj) { f32x4 v0 = acc[ai][bj][m][0] * s, v1 = acc[ai][bj][m][1] * s;
                        if (pn < 4) { v0 = gelu4(v0); v1 = gelu4(v1); }
                        if (pn == 2 || pn == 3) { s1 += ((v0[0] + v0[1]) + (v0[2] + v0[3])) + ((v1[0] + v1[1]) + (v1[2] + v1[3]));
                            s2 += ((v0[0] * v0[0] + v0[1] * v0[1]) + (v0[2] * v0[2] + v0[3] * v0[3])) + ((v1[0] * v1[0] + v1[1] * v1[1]) + (v1[2] * v1[2] + v1[3] * v1[3])); }
                        *(u32x4*)(base + (size_t)r * 512 + colt + bj * HALF) = pack8(v0, v1); }
                    if (pn == 2 || pn == 3) { s1 += __shfl_xor(s1, 16); s1 += __shfl_xor(s1, 32); s2 += __shfl_xor(s2, 16); s2 += __shfl_xor(s2, 32);
                        if (fq == 0) *(f32x2*)(vst + (size_t)r * 16 + ((pn - 2) * 4 + wc) * 2) = (f32x2){s1, s2}; } }
        } else {
            const int colt = (pn - 6) * 128 + cl;
#pragma unroll
            for (int ai = 0; ai < 2; ++ai)
#pragma unroll
                for (int m = 0; m < 4; ++m) { const int r = row0 + ai * HALF + m * 16; const float s2 = rs[ai][m] * rs[ai][m];
                    const f32x4 z0 = acc[ai][0][m][0] * acc[ai][1][m][0] * s2, z1 = acc[ai][0][m][1] * acc[ai][1][m][1] * s2;
                    *(u32x4*)(U4 + (size_t)3 * ((size_t)32768 * 512) + (size_t)r * 512 + colt) = pack8(z0, z1); }
        }
    }
};

struct EpiRes {
    static constexpr bool PERM = false, AFTER_DRAIN = false;
    const float* res; float* out; bf16_t* xb; float* ssq;
    __device__ __forceinline__ void init(f32x4 (&acc)[2][2][4][2], const Unit& u, int wr, int wc, int fr, int fq) const {
        const int row0 = u.pm * BM + wr * 64 + fr, col0 = u.pn * BM + wc * 32 + 4 * fq;
#pragma unroll
        for (int ai = 0; ai < 2; ++ai)
#pragma unroll
            for (int bj = 0; bj < 2; ++bj)
#pragma unroll
                for (int m = 0; m < 4; ++m)
#pragma unroll
                    for (int n = 0; n < 2; ++n) acc[ai][bj][m][n] = *(const f32x4*)(res + (size_t)(row0 + ai * HALF + m * 16) * 1024 + col0 + bj * HALF + n * 16);
    }
    __device__ __forceinline__ void operator()(const f32x4 (&acc)[2][2][4][2], const Unit& u, int wr, int wc, int fr, int fq) const {
        const int row0 = u.pm * BM + wr * 64 + fr, col0 = u.pn * BM + wc * 32 + 4 * fq;
#pragma unroll
        for (int ai = 0; ai < 2; ++ai)
#pragma unroll
            for (int m = 0; m < 4; ++m) { const int r = row0 + ai * HALF + m * 16; const size_t off = (size_t)r * 1024 + col0; float ss = 0.f;
#pragma unroll
                for (int bj = 0; bj < 2; ++bj)
#pragma unroll
                    for (int n = 0; n < 2; ++n) { const f32x4 v = acc[ai][bj][m][n];
                        *(f32x4*)(out + off + bj * HALF + n * 16) = v;
                        u32x2 w; w.x = cvt_pk_bf16(v[0], v[1]); w.y = cvt_pk_bf16(v[2], v[3]); *(u32x2*)(xb + off + bj * HALF + n * 16) = w;
                        ss += (v[0] * v[0] + v[1] * v[1]) + (v[2] * v[2] + v[3] * v[3]); }
                ss += __shfl_xor(ss, 16); ss += __shfl_xor(ss, 32);
                if (fq == 0) ssq[(size_t)r * SSQ_SLOTS + u.pn * 4 + wc] = ss; }
    }
};

struct EpiSwiglu {
    static constexpr bool PERM = true, AFTER_DRAIN = false;
    RstdTab T; bf16_t* act;
    __device__ __forceinline__ void init(f32x4 (&acc)[2][2][4][2], const Unit&, int, int, int, int) const {
#pragma unroll
        for (int a = 0; a < 2; ++a)
#pragma unroll
            for (int b = 0; b < 2; ++b)
#pragma unroll
                for (int m = 0; m < 4; ++m)
#pragma unroll
                    for (int n = 0; n < 2; ++n) acc[a][b][m][n] = (f32x4){0.f, 0.f, 0.f, 0.f};
    }
    __device__ __forceinline__ void operator()(const f32x4 (&acc)[2][2][4][2], const Unit& u, int wr, int wc, int fr, int fq) const {
        const int row0 = u.pm * BM + wr * 64 + fr, colt = u.pn * 128 + wc * 32 + 8 * fq;
#pragma unroll
        for (int ai = 0; ai < 2; ++ai)
#pragma unroll
            for (int m = 0; m < 4; ++m) { const int r = row0 + ai * HALF + m * 16; const float s = T.get(u.pm, wr * 64 + fr + ai * HALF + m * 16);
                f32x4 o[2];
#pragma unroll
                for (int n = 0; n < 2; ++n) { const f32x4 g = acc[ai][0][m][n] * s, up = acc[ai][1][m][n] * s;
                    o[n] = (f32x4){silu1(g[0]) * up[0], silu1(g[1]) * up[1], silu1(g[2]) * up[2], silu1(g[3]) * up[3]}; }
                *(u32x4*)(act + (size_t)r * 2816 + colt) = pack8(o[0], o[1]); }
    }
};

struct EpiQKV {
    static constexpr bool PERM = true, AFTER_DRAIN = false;
    RstdTab T; bf16_t* Q;
    __device__ __forceinline__ void init(f32x4 (&acc)[2][2][4][2], const Unit&, int, int, int, int) const {
#pragma unroll
        for (int a = 0; a < 2; ++a)
#pragma unroll
            for (int b = 0; b < 2; ++b)
#pragma unroll
                for (int m = 0; m < 4; ++m)
#pragma unroll
                    for (int n = 0; n < 2; ++n) acc[a][b][m][n] = (f32x4){0.f, 0.f, 0.f, 0.f};
    }
    __device__ __forceinline__ void operator()(const f32x4 (&acc)[2][2][4][2], const Unit& u, int wr, int wc, int fr, int fq) const {
        const int row0 = u.pm * BM + wr * 64 + fr, pn = u.pn, cl = wc * 32 + 8 * fq;
        bf16_t* base = pn < 4 ? Q + pn * 256 : Q + (size_t)32768 * 1024 + (size_t)(pn - 4) * ((size_t)32768 * 256); const int ld = pn < 4 ? 1024 : 256;
#pragma unroll
        for (int ai = 0; ai < 2; ++ai)
#pragma unroll
            for (int m = 0; m < 4; ++m) { const int r = row0 + ai * HALF + m * 16; const float s = T.get(u.pm, wr * 64 + fr + ai * HALF + m * 16);
#pragma unroll
                for (int bj = 0; bj < 2; ++bj) *(u32x4*)(base + (size_t)r * ld + cl + bj * HALF) = pack8(acc[ai][bj][m][0] * s, acc[ai][bj][m][1] * s); }
    }
};

template <class Epi, class Sched, bool ALIGN_EPI = false, bool SP2 = false>
__device__ __forceinline__ void gemm_phase(PG8_LAS unsigned char* lds, const Gemm g, const Sched& S, const Epi& E) {
    const int tid = threadIdx.x, wid = __builtin_amdgcn_readfirstlane(tid >> 6), lane = tid & 63, wr = wid >> 2, wc = wid & 3, fr = lane & 15, fq = lane >> 4;
    const int K = g.K, nt = K / BK;
    unsigned voffA[2], voffB[2];
#pragma unroll
    for (int i = 0; i < 2; ++i) { int R, C; stage_rc(tid * 16 + i * 8192, R, C); const int Rb = Epi::PERM ? ((R & ~31) + perm32(R & 31)) : R;
        voffA[i] = (unsigned)(R * K + C) * 2u; voffB[i] = (unsigned)(Rb * K + C) * 2u; }
    const size_t kstep = (size_t)(BK * 2);
    const size_t hstep = (size_t)HALF * K * 2;
    const size_t tstep = 2 * hstep;
    const unsigned ldsw = (unsigned)wid * 1024u;
    const int aoff = lds_byte(wr * 64 + fr, fq * 8), boff = lds_byte(wc * 32 + fr, fq * 8);
#define PG8_SA(b, h) (((b) * 2 + (h)) * HTB)
#define PG8_SB(b, h) ((4 + (b) * 2 + (h)) * HTB)
#define PG8_STAGE(bufoff, gbase, voff) do { _Pragma("unroll") for (int _i = 0; _i < 2; ++_i) \
        __builtin_amdgcn_global_load_lds((const unsigned*)((const char*)(gbase) + (voff)[_i]), (PG8_LAS unsigned*)(lds + (bufoff) + ldsw + _i * 8192), 16, 0, 0); } while (0)
#define PG8_LDA(dst, b, h) do { _Pragma("unroll") for (int m = 0; m < 4; ++m) _Pragma("unroll") for (int k = 0; k < 2; ++k) dst[m][k] = *(const PG8_LAS bf16x8*)(lds + PG8_SA(b, h) + aoff + m * 2048 + k * 1024); } while (0)
#define PG8_LDB(dst, b, h) do { _Pragma("unroll") for (int n = 0; n < 2; ++n) _Pragma("unroll") for (int k = 0; k < 2; ++k) dst[n][k] = *(const PG8_LAS bf16x8*)(lds + PG8_SB(b, h) + boff + n * 2048 + k * 1024); } while (0)
#define PG8_MMA(ai, bj, At, Bt) do { __builtin_amdgcn_s_setprio(1); _Pragma("unroll") for (int m = 0; m < 4; ++m) _Pragma("unroll") for (int n = 0; n < 2; ++n) _Pragma("unroll") for (int k = 0; k < 2; ++k) \
        acc[ai][bj][m][n] = __builtin_amdgcn_mfma_f32_16x16x32_bf16(Bt[n][k], At[m][k], acc[ai][bj][m][n], 0, 0, 0); __builtin_amdgcn_s_setprio(0); } while (0)
#define PG8_WAIT_V(n) asm volatile("s_waitcnt vmcnt(" #n ")" ::: "memory")
#define PG8_WAIT_L(n) asm volatile("s_waitcnt lgkmcnt(" #n ")" ::: "memory")
#define PG8_BAR __builtin_amdgcn_s_barrier()
#define PG8_SCHED __builtin_amdgcn_sched_barrier(0)
    Unit cur, nxt; int ui = 0;
    if (!S.next(0, cur)) return;
    f32x4 acc[2][2][4][2];
    E.init(acc, cur, wr, wc, fr, fq);
    bf16x8 At[4][2], B0[2][2], B1[2][2];
    const char* cA = (const char*)g.A + (size_t)cur.pm * tstep; const char* cB = (const char*)g.Bt + (size_t)cur.pn * tstep;
    S.a_ready(cur);
    if constexpr (SP2) {
        PG8_STAGE(PG8_SB(0, 0), cB, voffB); PG8_STAGE(PG8_SB(0, 1), cB + hstep, voffB); PG8_STAGE(PG8_SA(0, 0), cA, voffA); PG8_STAGE(PG8_SA(0, 1), cA + hstep, voffA);
        if (wr == 1) PG8_BAR;
        PG8_WAIT_V(2); PG8_BAR;
        PG8_STAGE(PG8_SB(1, 0), cB + kstep, voffB); PG8_STAGE(PG8_SA(1, 0), cA + kstep, voffA); PG8_STAGE(PG8_SB(1, 1), cB + hstep + kstep, voffB);
        PG8_WAIT_V(6); PG8_BAR;
    } else {
        PG8_STAGE(PG8_SB(0, 0), cB, voffB); PG8_STAGE(PG8_SA(0, 0), cA, voffA); PG8_STAGE(PG8_SB(0, 1), cB + hstep, voffB); PG8_STAGE(PG8_SA(0, 1), cA + hstep, voffA);
        if (wr == 1) PG8_BAR;
        PG8_WAIT_V(4); PG8_BAR;
        PG8_STAGE(PG8_SB(1, 0), cB + kstep, voffB); PG8_STAGE(PG8_SA(1, 0), cA + kstep, voffA); PG8_STAGE(PG8_SB(1, 1), cB + hstep + kstep, voffB);
        PG8_WAIT_V(6); PG8_BAR;
    }
    for (;;) {
        const bool has_next = S.next(ui + 1, nxt);
        const char* nA = has_next ? (const char*)g.A + (size_t)nxt.pm * tstep : cA; const char* nB = has_next ? (const char*)g.Bt + (size_t)nxt.pn * tstep : cB;
        for (int t = 0; t < nt; t += 2) {
            const bool last = (t == nt - 2);
            const char* a1 = cA + (size_t)(t + 1) * kstep;
            const char* a2 = last ? nA : cA + (size_t)(t + 2) * kstep; const char* b2 = last ? nB : cB + (size_t)(t + 2) * kstep;
            const char* a3 = a2 + kstep; const char* b3 = b2 + kstep;
            if (last && has_next) S.a_ready(nxt);
            if constexpr (SP2) {
            PG8_LDB(B0, 0, 0); PG8_LDB(B1, 0, 1); PG8_SCHED; PG8_LDA(At, 0, 0); PG8_STAGE(PG8_SA(1, 1), a1 + hstep, voffA);
            PG8_WAIT_V(8); PG8_WAIT_L(0); PG8_BAR; PG8_MMA(0, 0, At, B0); PG8_MMA(0, 1, At, B1); PG8_BAR; PG8_SCHED;
            PG8_LDA(At, 0, 1); PG8_STAGE(PG8_SB(0, 0), b2, voffB); PG8_STAGE(PG8_SB(0, 1), b2 + hstep, voffB); PG8_STAGE(PG8_SA(0, 0), a2, voffA);
            PG8_WAIT_V(8); PG8_WAIT_L(0); PG8_BAR; PG8_MMA(1, 0, At, B0); PG8_MMA(1, 1, At, B1); PG8_BAR; PG8_SCHED;
            PG8_LDB(B0, 1, 0); PG8_LDB(B1, 1, 1); PG8_SCHED; PG8_LDA(At, 1, 0); PG8_STAGE(PG8_SA(0, 1), a2 + hstep, voffA);
            PG8_WAIT_V(8); PG8_WAIT_L(0); PG8_BAR; PG8_MMA(0, 0, At, B0); PG8_MMA(0, 1, At, B1); PG8_BAR; PG8_SCHED;
            PG8_LDA(At, 1, 1); PG8_STAGE(PG8_SB(1, 0), b3, voffB); PG8_STAGE(PG8_SB(1, 1), b3 + hstep, voffB); PG8_STAGE(PG8_SA(1, 0), a3, voffA);
            PG8_WAIT_V(8); PG8_WAIT_L(0); PG8_BAR; PG8_MMA(1, 0, At, B0); PG8_MMA(1, 1, At, B1); PG8_BAR; PG8_SCHED;
            } else {
            PG8_LDB(B0, 0, 0); PG8_SCHED; PG8_LDA(At, 0, 0); PG8_STAGE(PG8_SA(1, 1), a1 + hstep, voffA);
            PG8_WAIT_L(8); PG8_BAR; PG8_WAIT_L(0); PG8_MMA(0, 0, At, B0); PG8_BAR; PG8_SCHED;
            PG8_LDB(B1, 0, 1); PG8_STAGE(PG8_SB(0, 0), b2, voffB);
            PG8_BAR; PG8_WAIT_L(0); PG8_MMA(0, 1, At, B1); PG8_BAR;
            PG8_LDA(At, 0, 1); PG8_STAGE(PG8_SA(0, 0), a2, voffA);
            PG8_BAR; PG8_WAIT_L(0); PG8_MMA(1, 0, At, B0); PG8_BAR; PG8_SCHED;
            PG8_STAGE(PG8_SB(0, 1), b2 + hstep, voffB);
            PG8_WAIT_V(6); PG8_BAR; PG8_MMA(1, 1, At, B1); PG8_BAR;
            PG8_LDB(B0, 1, 0); PG8_SCHED; PG8_LDA(At, 1, 0); PG8_STAGE(PG8_SA(0, 1), a2 + hstep, voffA);
            PG8_WAIT_L(8); PG8_BAR; PG8_WAIT_L(0); PG8_MMA(0, 0, At, B0); PG8_BAR; PG8_SCHED;
            PG8_LDB(B1, 1, 1); PG8_STAGE(PG8_SB(1, 0), b3, voffB);
            PG8_BAR; PG8_WAIT_L(0); PG8_MMA(0, 1, At, B1); PG8_BAR;
            PG8_LDA(At, 1, 1); PG8_STAGE(PG8_SA(1, 0), a3, voffA);
            PG8_BAR; PG8_WAIT_L(0); PG8_MMA(1, 0, At, B0); PG8_BAR; PG8_SCHED;
            PG8_STAGE(PG8_SB(1, 1), b3 + hstep, voffB);
            PG8_WAIT_V(6); PG8_BAR; PG8_MMA(1, 1, At, B1); PG8_BAR;
            }
        }
        if constexpr (ALIGN_EPI) { if (wr == 0) PG8_BAR; }
        if constexpr (!Epi::AFTER_DRAIN) { E(acc, cur, wr, wc, fr, fq); S.done(cur); }
        if (!has_next) break;
        E.init(acc, nxt, wr, wc, fr, fq);
        cur = nxt; cA = nA; cB = nB; ++ui;
        if constexpr (ALIGN_EPI) { if (wr == 1) PG8_BAR; }
    }
    PG8_WAIT_V(0);
    if constexpr (!ALIGN_EPI) { if (wr == 0) PG8_BAR; }
    PG8_BAR;
    if constexpr (Epi::AFTER_DRAIN) { E.fused(acc, cur, wr, wc, fr, fq, lds, wid, lane); S.done(cur); }
#undef PG8_SA
#undef PG8_SB
#undef PG8_STAGE
#undef PG8_LDA
#undef PG8_LDB
#undef PG8_MMA
#undef PG8_WAIT_V
#undef PG8_WAIT_L
#undef PG8_BAR
#undef PG8_SCHED
}
}

namespace att {
#define ALDS __attribute__((address_space(3)))
typedef unsigned short bf16_t;
typedef short bf16x8 __attribute__((ext_vector_type(8)));
typedef short s16x4 __attribute__((ext_vector_type(4)));
typedef float f32x16 __attribute__((ext_vector_type(16)));
typedef float f32x4 __attribute__((ext_vector_type(4)));
typedef unsigned u32x4 __attribute__((ext_vector_type(4)));
constexpr int SEQ_ = 4096, NKVH = 4, SLOT = 16384, NSLOT = 5, BT = 392;
constexpr int L_KV = 0, L_BIAS = NSLOT * SLOT, L_WS = L_BIAS + 4 * 4 * BT * 4, L_OST = L_WS + 8 * 64 * 4, L_END = L_OST + 8 * 4096;
constexpr float LOG2E = 1.4426950408889634f;
__device__ __forceinline__ int crow(int r, int hi) { return (r & 3) + 8 * (r >> 2) + 4 * hi; }
__device__ __forceinline__ int t5_bucket(int rel) {
    const int n = rel < 0 ? -rel : rel; int b;
    if (n < 8) b = n; else { const int lg = 31 - __clz(n * n); b = 8 + (lg - 6); if (b > 15) b = 15; }
    return (rel > 0 ? 16 : 0) + b;
}
__device__ __forceinline__ unsigned cvtpk(float lo, float hi) { unsigned r; asm volatile("v_cvt_pk_bf16_f32 %0, %1, %2" : "=v"(r) : "v"(lo), "v"(hi)); return r; }
__device__ __forceinline__ s16x4 vtr(const ALDS unsigned char* p) { typedef short v4i16_t __attribute__((ext_vector_type(4))); return __builtin_bit_cast(s16x4, __builtin_amdgcn_ds_read_tr16_b64_v4i16((ALDS v4i16_t*)p)); }

__device__ __forceinline__ void att_phase(ALDS unsigned char* lds, const bf16_t* Q, const bf16_t* K, const bf16_t* V, bf16_t* O, const float* sink, const float* relb, int vcu, int G) {
    const int tid = threadIdx.x, lane = tid & 63, r32 = lane & 31, hi = lane >> 5, wid = __builtin_amdgcn_readfirstlane(tid >> 6);
    const int NUNIT = 8 * NKVH * (SEQ_ / 64);
    const int upc = (NUNIT + G - 1) / G;
    ALDS float* wsf = (ALDS float*)(lds + L_WS) + wid * 64;
    int cur_pair = -1;
    for (int i = 0; i < upc; ++i) {
        const int unit = vcu * upc + i; if (unit >= NUNIT) break;
        const int pair = unit >> 6, qb = unit & 63, b = pair >> 2, kvh = pair & 3;
        __syncthreads();
        if (pair != cur_pair) {
            for (int idx = tid; idx < 4 * 4 * BT; idx += 512) { const int hd = idx / (4 * BT), rem = idx - hd * 4 * BT, s = rem / BT, j = rem - s * BT, rel = j - s - 192;
                float v = -1e30f; if (rel >= -128 && rel <= 128) v = relb[t5_bucket(rel) * 16 + kvh * 4 + hd] * LOG2E;
                ((ALDS float*)(lds + L_BIAS))[idx] = v; }
            cur_pair = pair; }
        const int t_lo = qb - 2 < 0 ? 0 : qb - 2, t_hi = qb + 2 > 63 ? 63 : qb + 2;
        const size_t rowbase = (size_t)b * SEQ_;
        for (int t = t_lo; t <= t_hi; ++t) { const int s = t - (qb - 2);
            const u32x4 kv = *(const u32x4*)(K + (rowbase + 64 * t + lane) * 256 + kvh * 64 + wid * 8);
            const u32x4 vv = *(const u32x4*)(V + (rowbase + 64 * t + 16 * (wid & 3) + (lane >> 2)) * 256 + kvh * 64 + (wid >> 2) * 32 + (lane & 3) * 8);
            *(ALDS u32x4*)(lds + s * SLOT + wid * 1024 + lane * 16) = kv;
            *(ALDS u32x4*)(lds + s * SLOT + 8192 + wid * 1024 + lane * 16) = vv; }
        const int head = kvh * 4 + (wid & 3), q0w = qb * 64 + (wid >> 2) * 32;
        bf16x8 qr[4];
#pragma unroll
        for (int d0 = 0; d0 < 4; ++d0) qr[d0] = *(const bf16x8*)(Q + (rowbase + q0w + r32) * 1024 + head * 64 + d0 * 16 + hi * 8);
        __syncthreads();
        float m = sink[head] * LOG2E, l = hi == 0 ? 1.f : 0.f;
        f32x16 o0, o1;
#pragma unroll
        for (int r = 0; r < 16; ++r) { o0[r] = 0.f; o1[r] = 0.f; }
        const ALDS float* tb = (const ALDS float*)(lds + L_BIAS) + ((wid & 3) * 4 + (r32 & 3)) * BT;
        for (int t = t_lo; t <= t_hi; ++t) {
            const ALDS unsigned char* Ks = lds + (t - (qb - 2)) * SLOT; const ALDS unsigned char* Vs = Ks + 8192;
            f32x16 p0, p1;
#pragma unroll
            for (int r = 0; r < 16; ++r) { p0[r] = 0.f; p1[r] = 0.f; }
#pragma unroll
            for (int d0 = 0; d0 < 4; ++d0) {
                const bf16x8 b0 = *(const ALDS bf16x8*)(Ks + hi * 1024 + r32 * 16 + d0 * 2048);
                const bf16x8 b1 = *(const ALDS bf16x8*)(Ks + hi * 1024 + r32 * 16 + d0 * 2048 + 512);
                p0 = __builtin_amdgcn_mfma_f32_32x32x16_bf16(b0, qr[d0], p0, 0, 0, 0);
                p1 = __builtin_amdgcn_mfma_f32_32x32x16_bf16(b1, qr[d0], p1, 0, 0, 0); }
            const int ib = 64 * t - q0w + 192 - (r32 & ~3) + 4 * hi;
#pragma unroll
            for (int g = 0; g < 4; ++g) { const f32x4 f0 = *(const ALDS f32x4*)(tb + ib + 8 * g), f1 = *(const ALDS f32x4*)(tb + ib + 32 + 8 * g);
#pragma unroll
                for (int e = 0; e < 4; ++e) { p0[4 * g + e] += f0[e]; p1[4 * g + e] += f1[e]; } }
            float rm = fmaxf(p0[0], p1[0]);
#pragma unroll
            for (int r = 1; r < 16; ++r) rm = fmaxf(rm, fmaxf(p0[r], p1[r]));
            rm = fmaxf(rm, __shfl_xor(rm, 32));
            const float mn = fmaxf(m, rm), alpha = __builtin_amdgcn_exp2f(m - mn); m = mn;
            float ps = 0.f;
#pragma unroll
            for (int r = 0; r < 16; ++r) { p0[r] = __builtin_amdgcn_exp2f(p0[r] - mn); p1[r] = __builtin_amdgcn_exp2f(p1[r] - mn); ps += p0[r] + p1[r]; }
            l = l * alpha + ps;
            if (hi == 0) wsf[r32] = alpha;
#pragma unroll
            for (int r = 0; r < 16; ++r) { const float a = wsf[crow(r, hi)]; o0[r] *= a; o1[r] *= a; }
            u32x4 pw[4];
#pragma unroll
            for (int k = 0; k < 2; ++k) { pw[k] = (u32x4){cvtpk(p0[8 * k], p0[8 * k + 1]), cvtpk(p0[8 * k + 2], p0[8 * k + 3]), cvtpk(p0[8 * k + 4], p0[8 * k + 5]), cvtpk(p0[8 * k + 6], p0[8 * k + 7])};
                pw[2 + k] = (u32x4){cvtpk(p1[8 * k], p1[8 * k + 1]), cvtpk(p1[8 * k + 2], p1[8 * k + 3]), cvtpk(p1[8 * k + 4], p1[8 * k + 5]), cvtpk(p1[8 * k + 6], p1[8 * k + 7])}; }
            const ALDS unsigned char* vp = Vs + ((lane >> 4) & 1) * 32 + (lane & 3) * 8 + (4 * hi + ((lane & 15) >> 2)) * 64;
#pragma unroll
            for (int ks = 0; ks < 4; ++ks) { const bf16x8 pa = __builtin_bit_cast(bf16x8, pw[ks]);
                { const s16x4 lo = vtr(vp + ks * 1024), hh = vtr(vp + ks * 1024 + 512); const bf16x8 vf = (bf16x8){lo[0], lo[1], lo[2], lo[3], hh[0], hh[1], hh[2], hh[3]};
                  o0 = __builtin_amdgcn_mfma_f32_32x32x16_bf16(pa, vf, o0, 0, 0, 0); }
                { const s16x4 lo = vtr(vp + 4096 + ks * 1024), hh = vtr(vp + 4096 + ks * 1024 + 512); const bf16x8 vf = (bf16x8){lo[0], lo[1], lo[2], lo[3], hh[0], hh[1], hh[2], hh[3]};
                  o1 = __builtin_amdgcn_mfma_f32_32x32x16_bf16(pa, vf, o1, 0, 0, 0); } }
        }
        l += __shfl_xor(l, 32);
        if (hi == 0) wsf[32 + r32] = l;
        ALDS bf16_t* stg = (ALDS bf16_t*)(lds + L_OST) + wid * 2048;
#pragma unroll
        for (int r = 0; r < 16; ++r) { const int orow = crow(r, hi); const float rl = __builtin_amdgcn_rcpf(wsf[32 + orow]);
            const unsigned a = cvtpk(o0[r] * rl, o1[r] * rl);
            stg[orow * 64 + r32] = (bf16_t)(a & 0xffffu); stg[orow * 64 + 32 + r32] = (bf16_t)(a >> 16); }
        bf16_t* Ow = O + (rowbase + q0w) * 1024 + head * 64;
#pragma unroll
        for (int j = 0; j < 4; ++j) { const int row = j * 8 + (lane >> 3), ch = lane & 7; const u32x4 v = *(const ALDS u32x4*)(stg + row * 64 + ch * 8); *(u32x4*)(Ow + (size_t)row * 1024 + ch * 8) = v; }
    }
    __syncthreads();
}
#undef ALDS
}

constexpr int NWAVES = 8;
constexpr int N_PHASES = 12;

constexpr size_t WS_CTL = 0, CTL_ZERO_BYTES = 1 * MiB;
constexpr size_t WS_WIN = 2 * MiB, WS_WO0 = 7 * MiB, WS_WGU0 = 9 * MiB, WS_WD0 = 20 * MiB, WS_WQKV = 26 * MiB, WS_WO1 = 29 * MiB, WS_WGU1 = 31 * MiB, WS_WD1 = 42 * MiB;
constexpr size_t WS_WSP = 48 * MiB;
constexpr size_t WS_SSQ = 49 * MiB;
constexpr size_t WS_VST = 51 * MiB;
constexpr size_t WS_XB = 56 * MiB;
constexpr size_t WS_A = 128 * MiB;
constexpr size_t WS_U = WS_A, WS_V = WS_A + 32 * MiB, WS_BB = WS_A + 64 * MiB, WS_Z = WS_A + 96 * MiB, WS_Y = WS_A + 128 * MiB;
constexpr size_t WS_ACT = WS_A;
constexpr size_t WS_Q = WS_A, WS_K = WS_A + 64 * MiB, WS_VV = WS_A + 80 * MiB, WS_O = WS_A + 96 * MiB;
constexpr size_t WS_OPT_END = 320 * MiB;
constexpr int CW_TMO = 0, CW_CODE = 1;
constexpr int CW_BAR = 4096;

constexpr int RING_OFF = 0, RING_BYTES = 131072;
constexpr int RSTD_OFF = 150528;
constexpr int MISC_OFF = 153600;
constexpr int LDS_BYTES = 155648;
static_assert(WS_V - WS_U == (size_t)MTOK * 512 * 2 && WS_BB - WS_V == WS_V - WS_U && WS_Z - WS_BB == WS_V - WS_U && WS_K - WS_Q == (size_t)MTOK * 1024 * 2 && WS_VV - WS_K == (size_t)MTOK * 256 * 2, "tensor strides the epilogues assume");
static_assert(att::L_END <= RSTD_OFF && RSTD_OFF + 2048 <= MISC_OFF && MISC_OFF + 128 <= LDS_BYTES, "LDS map");

#define GAS __attribute__((address_space(1)))
#define LAS __attribute__((address_space(3)))
typedef unsigned short bf16;
typedef unsigned v4u __attribute__((ext_vector_type(4)));
typedef unsigned v2u __attribute__((ext_vector_type(2)));
typedef float f32x4 __attribute__((ext_vector_type(4)));
typedef short bf16x8 __attribute__((ext_vector_type(8)));
typedef GAS unsigned gu32;
typedef GAS unsigned long long gu64;
#define RLX_AGENT __ATOMIC_RELAXED, __HIP_MEMORY_SCOPE_AGENT
#define LDS_WAIT() asm volatile("s_waitcnt lgkmcnt(0)" ::: "memory")
#define VM_WAIT() asm volatile("s_waitcnt vmcnt(0)" ::: "memory")
__device__ __forceinline__ unsigned f2bf(float f) { unsigned u = __builtin_bit_cast(unsigned, f); return (u + 0x7fffu + ((u >> 16) & 1u)) >> 16; }
__device__ __forceinline__ unsigned pk2(float lo, float hi) { return f2bf(lo) | (f2bf(hi) << 16); }
__device__ __forceinline__ float bflo(unsigned w) { return __builtin_bit_cast(float, w << 16); }
__device__ __forceinline__ float bfhi(unsigned w) { return __builtin_bit_cast(float, w & 0xffff0000u); }

#define XB_TMO      128
#define XB_XCNT(j)  (256  + 64 * (j))
#define XB_XSUB(j)  (1280 + 64 * (j))
#define XB_XGEN(j)  (2304 + 64 * (j))
#define XB_TOP      3328
#define XB_TOPGEN   3392
#define XCD_BAR_WORDS 3456
#define XB_SPIN_CAP (1u << 18)

__device__ __forceinline__ unsigned xb_ld(unsigned* p)              { return __hip_atomic_load(p, __ATOMIC_RELAXED, __HIP_MEMORY_SCOPE_AGENT); }
__device__ __forceinline__ unsigned xb_add(unsigned* p, unsigned v) { return __hip_atomic_fetch_add(p, v, __ATOMIC_RELAXED, __HIP_MEMORY_SCOPE_AGENT); }
__device__ __forceinline__ unsigned xb_xcc_id() { return (unsigned)__builtin_amdgcn_s_getreg((3 << 11) | 20) & 0xFu; }
#define XB_SPIN(cond, bar) do { unsigned _sp = 0; while (cond) { __builtin_amdgcn_s_sleep(1); \
    if ((++_sp & 255u) == 0u) { if (xb_ld(&(bar)[XB_TMO])) break; if (_sp > XB_SPIN_CAP) { atomicAdd(&(bar)[XB_TMO], 1u); break; } } } } while (0)

struct XcdBarrier {
    unsigned* bar; unsigned x;
    volatile LAS unsigned* st;
};

__device__ __forceinline__ XcdBarrier xcd_barrier_post(unsigned* bar, volatile LAS unsigned* st) {
    XcdBarrier b; b.bar = bar; b.x = xb_xcc_id(); b.st = st;
    if (threadIdx.x == 0) (void)xb_add(&bar[XB_XCNT(b.x)], 1u);
    return b;
}
__device__ __forceinline__ void xcd_barrier_complete(unsigned* bar, unsigned x, unsigned& nloc, unsigned& nx) {
    const unsigned G = gridDim.x * gridDim.y * gridDim.z;
    unsigned sum, cnt, mine, sp = 0u;
    for (;;) {
        sum = 0u; cnt = 0u; mine = 0u;
#pragma unroll
        for (unsigned j = 0; j < 16; ++j) { const unsigned c = xb_ld(&bar[XB_XCNT(j)]); sum += c; cnt += (c > 0u) ? 1u : 0u; mine = (j == x) ? c : mine; }
        if (sum == G) break;
        __builtin_amdgcn_s_sleep(1);
        if ((++sp & 255u) == 0u) { if (xb_ld(&bar[XB_TMO])) break; if (sp > XB_SPIN_CAP) { atomicAdd(&bar[XB_TMO], 1u); break; } }
    }
    nloc = mine > 0u ? mine : 1u; nx = cnt > 0u ? cnt : 1u;
}

__device__ __forceinline__ void xcd_barrier(const XcdBarrier& b) {
    asm volatile("s_waitcnt vmcnt(0)" ::: "memory");
    __syncthreads();
    if (threadIdx.x == 0) {
        unsigned* bar = b.bar;
        __builtin_amdgcn_s_waitcnt(0);
        unsigned nloc = b.st[0], nx = b.st[1];
        if (nloc == 0u) { xcd_barrier_complete(bar, b.x, nloc, nx); b.st[0] = nloc; b.st[1] = nx; }
        const unsigned old = xb_add(&bar[XB_XSUB(b.x)], 1u);
        const unsigned gen = old / nloc;
        if (old + 1u == (gen + 1u) * nloc) {
            __builtin_amdgcn_fence(__ATOMIC_RELEASE, "agent");
            asm volatile("s_waitcnt vmcnt(0)" ::: "memory");
            const unsigned og = xb_add(&bar[XB_TOP], 1u);
            const unsigned tg = og / nx;
            if (og + 1u == (tg + 1u) * nx) xb_add(&bar[XB_TOPGEN], 1u);
            else XB_SPIN(xb_ld(&bar[XB_TOPGEN]) == tg, bar);
            __builtin_amdgcn_fence(__ATOMIC_ACQUIRE, "agent");
            xb_add(&bar[XB_XGEN(b.x)], 1u);
            asm volatile("s_waitcnt vmcnt(0)" ::: "memory");
        } else {
            XB_SPIN(xb_ld(&bar[XB_XGEN(b.x)]) == gen, bar);
            __builtin_amdgcn_fence(__ATOMIC_ACQUIRE, "agent");
            asm volatile("s_waitcnt vmcnt(0)" ::: "memory");
        }
    }
    __syncthreads();
}


struct Frame {
    LAS unsigned char* lds;
    volatile LAS unsigned* MISC;
    gu32* ctl;
    int tid, lane, wave;
    int vcu, G;
    float* out; unsigned char* ws;
};
struct Args { const float* in[18]; float* out; unsigned char* ws; int ph_lo, ph_hi, use_bar, pad; };

__device__ __forceinline__ float wave_sum(float v) {
#pragma unroll
    for (int o = 1; o < 64; o <<= 1) v += __shfl_xor(v, o);
    return v;
}

__device__ __forceinline__ void p0_transpose_item(const float* W, int ld, int c0, int k0, bf16* WT, int K, int drow, const float* gk, float sc, LAS float* scr, int lane) {
#pragma unroll 8
    for (int i = 0; i < 32; ++i) { const int kk = 2 * i + (lane >> 5); scr[kk * 33 + (lane & 31)] = W[(size_t)(k0 + kk) * ld + c0 + (lane & 31)]; }
    LDS_WAIT(); asm volatile("" ::: "memory");
    const int c = lane & 7;
    float g8[8];
#pragma unroll
    for (int e = 0; e < 8; ++e) g8[e] = (gk ? gk[k0 + 8 * c + e] : 1.0f) * sc;
#pragma unroll
    for (int j = 0; j < 4; ++j) { const int n = (lane >> 3) + 8 * j; const LAS float* s = scr + (8 * c) * 33 + n;
        v4u o; o.x = pk2(s[0 * 33] * g8[0], s[1 * 33] * g8[1]); o.y = pk2(s[2 * 33] * g8[2], s[3 * 33] * g8[3]); o.z = pk2(s[4 * 33] * g8[4], s[5 * 33] * g8[5]); o.w = pk2(s[6 * 33] * g8[6], s[7 * 33] * g8[7]);
        *(GAS v4u*)(WT + (size_t)(drow + n) * K + k0 + 8 * c) = o; }
    LDS_WAIT(); asm volatile("" ::: "memory");
}
constexpr float ATT_C2 = 0.125f * 1.4426950408889634f;
__device__ __forceinline__ void p0_prologue(Frame& F, const Args& A) {
    LAS float* scr = (LAS float*)(F.lds + RING_OFF + F.wave * 16384);
    const int gw = F.vcu * NWAVES + F.wave, NGW = F.G * NWAVES;
    unsigned char* ws = F.ws;
    constexpr int I_IN = 16 * 80, I_O = 16 * 32, I_GU = 16 * 176, I_D = 44 * 32, I_QKV = 16 * 48;
    constexpr int NITEMS = I_IN + 2 * I_O + 2 * I_GU + 2 * I_D + I_QKV;
    for (int it = gw; it < NITEMS; it += NGW) {
        int r = it;
        if (r < I_IN) { const int kb = r / 80, nb = r % 80, n = 32 * nb; int c0 = n;
            if (n >= 1536) { const int t = (n - 1536) >> 8, i = (n - 1536) & 255; c0 = i < 128 ? 1536 + 128 * t + i : 2048 + 128 * t + (i - 128); }
            p0_transpose_item(A.in[3], NIN, c0, 64 * kb, (bf16*)(ws + WS_WIN), DM, n, A.in[1], 1.0f, scr, F.lane); continue; } r -= I_IN;
        if (r < I_O) { const int kb = r / 32, nb = r % 32; p0_transpose_item(A.in[9], DM, 32 * nb, 64 * kb, (bf16*)(ws + WS_WO0), DM, 32 * nb, nullptr, 1.0f, scr, F.lane); continue; } r -= I_O;
        if (r < I_O) { const int kb = r / 32, nb = r % 32; p0_transpose_item(A.in[13], DM, 32 * nb, 64 * kb, (bf16*)(ws + WS_WO1), DM, 32 * nb, nullptr, 1.0f, scr, F.lane); continue; } r -= I_O;
        if (r < 2 * I_GU) { const int L = r / I_GU; r -= L * I_GU; const int kb = r / 176, nb = r % 176, n = 32 * nb, t = n >> 8, i = n & 255;
            const float* wg_ = A.in[14]; const float* wu_ = A.in[15]; const float* src = (i < 128 ? wg_ : wu_) + (size_t)L * DM * DFF; const int c0 = 128 * t + (i & 127);
            p0_transpose_item(src, DFF, c0, 64 * kb, (bf16*)(ws + (L ? WS_WGU1 : WS_WGU0)), DM, n, A.in[2] + L * DM, 1.0f, scr, F.lane); continue; } r -= 2 * I_GU;
        if (r < 2 * I_D) { const int L = r / I_D; r -= L * I_D; const int kb = r / 32, nb = r % 32;
            p0_transpose_item(A.in[16] + (size_t)L * DFF * DM, DM, 32 * nb, 64 * kb, (bf16*)(ws + (L ? WS_WD1 : WS_WD0)), DFF, 32 * nb, nullptr, 1.0f, scr, F.lane); continue; } r -= 2 * I_D;
        { const int kb = r / 48, nb = r % 48, n = 32 * nb;
            p0_transpose_item(A.in[10], NQKV, n, 64 * kb, (bf16*)(ws + WS_WQKV), DM, n, A.in[1] + DM, n < 1024 ? ATT_C2 : 1.0f, scr, F.lane); }
    }
    { const float* wsp = A.in[6]; bf16* o = (bf16*)(ws + WS_WSP);
      for (int i = (F.vcu * 512 + F.tid) * 2; i < NGRP * CHUNK * CHUNK; i += F.G * 512 * 2) *(GAS unsigned*)(o + i) = pk2(wsp[i], wsp[i + 1]); }
    { const float* x = A.in[0]; bf16* xb = (bf16*)(ws + WS_XB); float* ssq = (float*)(ws + WS_SSQ);
      for (int m = gw; m < MTOK; m += NGW) {
          const GAS f32x4* xr = (const GAS f32x4*)(x + (size_t)m * DM) + F.lane; f32x4 v[4]; float s = 0.f;
#pragma unroll
          for (int j = 0; j < 4; ++j) { v[j] = xr[64 * j]; s += (v[j].x * v[j].x + v[j].y * v[j].y) + (v[j].z * v[j].z + v[j].w * v[j].w); }
          s = wave_sum(s);
          GAS v2u* o8 = (GAS v2u*)(xb + (size_t)m * DM) + F.lane;
#pragma unroll
          for (int j = 0; j < 4; ++j) o8[64 * j] = (v2u){pk2(v[j].x, v[j].y), pk2(v[j].z, v[j].w)};
          if (F.lane < 16) ssq[(size_t)m * 16 + F.lane] = F.lane == 0 ? s : 0.f; } }
}

constexpr int MIX_VT_STRIDE = 272;
__device__ __forceinline__ void mix_phase(Frame& F, const Args& A) {
    typedef float f32x4m __attribute__((ext_vector_type(4)));
    unsigned char* ws = F.ws;
    const bf16* U = (const bf16*)(ws + WS_U); const bf16* V = (const bf16*)(ws + WS_V); const bf16* Bb = (const bf16*)(ws + WS_BB); const bf16* Z = (const bf16*)(ws + WS_Z);
    bf16* Y = (bf16*)(ws + WS_Y); const float* vst = (const float*)(ws + WS_VST); const bf16* Wsp = (const bf16*)(ws + WS_WSP);
    const float* lng = A.in[4]; const float* lnb = A.in[5]; const float* bsp = A.in[7]; const float* cw = A.in[8];
    LAS float* s_mu = (LAS float*)(F.lds + RING_OFF); LAS float* s_rs = s_mu + 128;
    LAS unsigned char* vnT = F.lds + RING_OFF + 1024;
    const int tid = F.tid, lane = F.lane, w = F.wave, fr = lane & 15, fq = lane >> 4;
    for (int item = F.vcu; item < MTOK / CHUNK; item += F.G) {
        const int R0 = item * CHUNK;
        __syncthreads();
        if (tid < 128) { const f32x4m* p = (const f32x4m*)(vst + (size_t)(R0 + tid) * 16); float s1 = 0.f, s2 = 0.f;
#pragma unroll
            for (int k = 0; k < 4; ++k) { const f32x4m a = p[k]; s1 += a[0] + a[2]; s2 += a[1] + a[3]; }
            const float mu = s1 * (1.0f / AW), var = fmaxf(s2 * (1.0f / AW) - mu * mu, 0.f);
            s_mu[tid] = mu; s_rs[tid] = 1.0f / sqrtf(var + EPS); }
        for (int g = 0; g < NGRP; ++g) {
            __syncthreads();
            { const int c8 = tid & 15; float gg[8], bb[8];
#pragma unroll
              for (int e = 0; e < 8; ++e) { gg[e] = lng[g * 128 + c8 * 8 + e]; bb[e] = lnb[g * 128 + c8 * 8 + e]; }
#pragma unroll
              for (int j = 0; j < 4; ++j) { const int q = (tid >> 4) + 32 * j;
                  const v4u raw = *(const GAS v4u*)(V + (size_t)(R0 + q) * AW + g * 128 + c8 * 8);
                  const float mu = s_mu[q], rs = s_rs[q];
                  const unsigned wv[4] = {raw.x, raw.y, raw.z, raw.w};
#pragma unroll
                  for (int e = 0; e < 8; ++e) { const float v = (e & 1) ? bfhi(wv[e >> 1]) : bflo(wv[e >> 1]); const float vn = (v - mu) * rs * gg[e] + bb[e];
                      const int ch = c8 * 8 + e, c = ch & 31, slot = (ch & ~31) + 16 * ((c >> 2) & 1) + 4 * (c >> 3) + (c & 3);
                      *(LAS unsigned short*)(vnT + slot * MIX_VT_STRIDE + q * 2) = (unsigned short)f2bf(vn); } } }
            __syncthreads();
            f32x4m acc[8];
#pragma unroll
            for (int n = 0; n < 8; ++n) acc[n] = (f32x4m){0.f, 0.f, 0.f, 0.f};
            bf16x8 wf[4];
#pragma unroll
            for (int kk = 0; kk < 4; ++kk) wf[kk] = *(const GAS bf16x8*)(Wsp + (size_t)(g * 128 + 16 * w + fr) * 128 + 32 * kk + 8 * fq);
#pragma unroll
            for (int n = 0; n < 8; ++n)
#pragma unroll
                for (int kk = 0; kk < 4; ++kk) { const bf16x8 vf = *(const LAS bf16x8*)(vnT + (16 * n + fr) * MIX_VT_STRIDE + (32 * kk + 8 * fq) * 2);
                    acc[n] = __builtin_amdgcn_mfma_f32_16x16x32_bf16(vf, wf[kk], acc[n], 0, 0, 0); }
            const int p = 16 * w + fr; const float bs = bsp[g * 128 + p];
#pragma unroll
            for (int j = 0; j < 4; ++j) { const size_t col = (size_t)g * 128 + 32 * j + 8 * fq;
                const v4u ur = *(const GAS v4u*)(U + (size_t)(R0 + p) * AW + col);
                const f32x4m a0 = acc[2 * j] + bs, a1 = acc[2 * j + 1] + bs;
                v4u o; o.x = pk2(bflo(ur.x) * a0[0], bfhi(ur.x) * a0[1]); o.y = pk2(bflo(ur.y) * a0[2], bfhi(ur.y) * a0[3]);
                o.z = pk2(bflo(ur.z) * a1[0], bfhi(ur.z) * a1[1]); o.w = pk2(bflo(ur.w) * a1[2], bfhi(ur.w) * a1[3]);
                *(GAS v4u*)(Y + (size_t)(R0 + p) * DM + col) = o; }
        }
        { const int c8 = tid & 63, rg = tid >> 6; float w0[8], w1[8], w2[8];
#pragma unroll
          for (int e = 0; e < 8; ++e) { w0[e] = cw[c8 * 8 + e]; w1[e] = cw[BW + c8 * 8 + e]; w2[e] = cw[2 * BW + c8 * 8 + e]; }
          const int rfirst = R0 + 16 * rg; const v4u zero = (v4u){0u, 0u, 0u, 0u};
          v4u zp = (rfirst & (SEQ - 1)) ? *(const GAS v4u*)(Z + (size_t)(rfirst - 1) * BW + c8 * 8) : zero;
          v4u zc = *(const GAS v4u*)(Z + (size_t)rfirst * BW + c8 * 8);
          for (int rr = 0; rr < 16; ++rr) { const int row = rfirst + rr;
              const v4u zn = ((row + 1) & (SEQ - 1)) ? *(const GAS v4u*)(Z + (size_t)(row + 1) * BW + c8 * 8) : zero;
              const v4u bv = *(const GAS v4u*)(Bb + (size_t)row * BW + c8 * 8);
              const unsigned zpw[4] = {zp.x, zp.y, zp.z, zp.w}, zcw[4] = {zc.x, zc.y, zc.z, zc.w}, znw[4] = {zn.x, zn.y, zn.z, zn.w}, bw[4] = {bv.x, bv.y, bv.z, bv.w};
              unsigned ow[4];
#pragma unroll
              for (int k = 0; k < 4; ++k) {
                  const float lo = bflo(bw[k]) * (bflo(zpw[k]) * w0[2 * k] + bflo(zcw[k]) * w1[2 * k] + bflo(znw[k]) * w2[2 * k]);
                  const float hi = bfhi(bw[k]) * (bfhi(zpw[k]) * w0[2 * k + 1] + bfhi(zcw[k]) * w1[2 * k + 1] + bfhi(znw[k]) * w2[2 * k + 1]);
                  ow[k] = pk2(lo, hi); }
              *(GAS v4u*)(Y + (size_t)row * DM + AW + c8 * 8) = (v4u){ow[0], ow[1], ow[2], ow[3]};
              zp = zc; zc = zn; } }
    }
    __syncthreads();
}

__device__ __forceinline__ void fin_phase(Frame& F, const Args& A) {
    const int gw = F.vcu * NWAVES + F.wave, NGW = F.G * NWAVES; const float* ssq = (const float*)(F.ws + WS_SSQ); const float* g = A.in[17];
    f32x4 gg[4];
#pragma unroll
    for (int j = 0; j < 4; ++j) gg[j] = ((const GAS f32x4*)g)[F.lane + 64 * j];
    for (int m = gw; m < MTOK; m += NGW) {
        const float rs = pg8::row_rstd(ssq, m);
        GAS f32x4* xr = (GAS f32x4*)(F.out + (size_t)m * DM) + F.lane;
#pragma unroll
        for (int j = 0; j < 4; ++j) { const f32x4 v = xr[64 * j]; xr[64 * j] = v * rs * gg[j]; }
    }
}

__global__ void __launch_bounds__(NWAVES * 64, 2) mk_fwd(Args args) {
    extern __shared__ __attribute__((aligned(16))) unsigned char lds[];
    Frame F;
    F.lds = (LAS unsigned char*)lds;
    F.MISC = (volatile LAS unsigned*)(F.lds + MISC_OFF);
    F.tid = threadIdx.x; F.lane = F.tid & 63; F.wave = __builtin_amdgcn_readfirstlane(F.tid >> 6);
    F.G = gridDim.x; { const int bx = blockIdx.x; F.vcu = (F.G % 8 == 0) ? (bx % 8) * (F.G / 8) + bx / 8 : bx; }
    F.out = args.out; F.ws = args.ws;
    unsigned char* ws = args.ws;
    F.ctl = (gu32*)(ws + WS_CTL);
    for (int u = F.tid; u < (LDS_BYTES - MISC_OFF) / 4; u += NWAVES * 64) ((LAS unsigned*)(F.lds + MISC_OFF))[u] = 0u;
    __syncthreads();
    XcdBarrier bar; bar.bar = (unsigned*)(F.ctl + CW_BAR); bar.x = 0; bar.st = nullptr;
    if (args.use_bar) bar = xcd_barrier_post((unsigned*)(F.ctl + CW_BAR), F.MISC + 8);
    const int lo = args.ph_lo, hi = args.ph_hi;
#ifndef MK_PHASE_MASK
#define MK_PHASE_MASK 0xFFF
#endif
#define IN(k) (((MK_PHASE_MASK >> (k)) & 1) && lo <= (k) && (k) < hi)
#define SEAM(k) do { if (IN(k) && IN((k) + 1)) { if (args.use_bar) xcd_barrier(bar); else { if (F.tid == 0) __hip_atomic_store(F.ctl + CW_TMO, 0xBADBA0u | (unsigned)(k), RLX_AGENT); } } } while (0)
    LAS float* rtab = (LAS float*)(F.lds + RSTD_OFF);
    const float* ssq = (const float*)(ws + WS_SSQ); float* ssqw = (float*)(ws + WS_SSQ);
    pg8::bf16_t* XB = (pg8::bf16_t*)(ws + WS_XB);

    if (IN(0)) { p0_prologue(F, args); } SEAM(0);
    if (IN(1)) {
        pg8::Gemm g{XB, (const pg8::bf16_t*)(ws + WS_WIN), MTOK, NIN, DM}; pg8::StaticOrder S; S.init(MTOK, NIN, F.G, (int)blockIdx.x);
        pg8::EpiMix1 E{pg8::fill_rstd_tab(rtab, ssq, S), (pg8::bf16_t*)(ws + WS_U), (float*)(ws + WS_VST)};
        pg8::gemm_phase<pg8::EpiMix1, pg8::StaticOrder, true, true>(F.lds + RING_OFF, g, S, E);
    } SEAM(1);
    if (IN(2)) { mix_phase(F, args); } SEAM(2);
    if (IN(3)) {
        pg8::Gemm g{(const pg8::bf16_t*)(ws + WS_Y), (const pg8::bf16_t*)(ws + WS_WO0), MTOK, DM, DM}; pg8::StaticOrder S; S.init(MTOK, DM, F.G, (int)blockIdx.x);
        pg8::EpiRes E{args.in[0], F.out, XB, ssqw};
        pg8::gemm_phase<pg8::EpiRes, pg8::StaticOrder, true, true>(F.lds + RING_OFF, g, S, E);
    } SEAM(3);
#define FFN_UP(pu, WGU) if (IN(pu)) {     \
        pg8::Gemm g{XB, (const pg8::bf16_t*)(ws + (WGU)), MTOK, 2 * DFF, DM}; pg8::StaticOrder S; S.init(MTOK, 2 * DFF, F.G, (int)blockIdx.x); \
        pg8::EpiSwiglu E{pg8::fill_rstd_tab(rtab, ssq, S), (pg8::bf16_t*)(ws + WS_ACT)}; \
        pg8::gemm_phase<pg8::EpiSwiglu, pg8::StaticOrder, true, true>(F.lds + RING_OFF, g, S, E); } SEAM(pu)
#define FFN_DOWN(pd, WD) if (IN(pd)) {     \
        pg8::Gemm g{(const pg8::bf16_t*)(ws + WS_ACT), (const pg8::bf16_t*)(ws + (WD)), MTOK, DM, DFF}; pg8::StaticOrder S; S.init(MTOK, DM, F.G, (int)blockIdx.x); \
        pg8::EpiRes E{F.out, F.out, XB, ssqw}; \
        pg8::gemm_phase<pg8::EpiRes, pg8::StaticOrder, true, true>(F.lds + RING_OFF, g, S, E); } SEAM(pd)
    FFN_UP(4, WS_WGU0);
    FFN_DOWN(5, WS_WD0);
    if (IN(6)) {
        pg8::Gemm g{XB, (const pg8::bf16_t*)(ws + WS_WQKV), MTOK, NQKV, DM}; pg8::StaticOrder S; S.init(MTOK, NQKV, F.G, (int)blockIdx.x);
        pg8::EpiQKV E{pg8::fill_rstd_tab(rtab, ssq, S), (pg8::bf16_t*)(ws + WS_Q)};
        pg8::gemm_phase<pg8::EpiQKV, pg8::StaticOrder, true, true>(F.lds + RING_OFF, g, S, E);
    } SEAM(6);
    if (IN(7)) { att::att_phase(F.lds + RING_OFF, (const att::bf16_t*)(ws + WS_Q), (const att::bf16_t*)(ws + WS_K), (const att::bf16_t*)(ws + WS_VV), (att::bf16_t*)(ws + WS_O), args.in[11], args.in[12], F.vcu, F.G); } SEAM(7);
    if (IN(8)) {
        pg8::Gemm g{(const pg8::bf16_t*)(ws + WS_O), (const pg8::bf16_t*)(ws + WS_WO1), MTOK, DM, DM}; pg8::StaticOrder S; S.init(MTOK, DM, F.G, (int)blockIdx.x);
        pg8::EpiRes E{F.out, F.out, XB, ssqw};
        pg8::gemm_phase<pg8::EpiRes, pg8::StaticOrder, true, true>(F.lds + RING_OFF, g, S, E);
    } SEAM(8);
    FFN_UP(9, WS_WGU1);
    FFN_DOWN(10, WS_WD1);
#undef FFN_UP
#undef FFN_DOWN
    if (IN(11)) { fin_phase(F, args); }
#undef IN
#undef SEAM
}

namespace simple {

__device__ __forceinline__ float wave_sum(float v) {
#pragma unroll
    for (int o = 1; o < 64; o <<= 1) v += __shfl_xor(v, o);
    return v;
}
__device__ __forceinline__ float wave_max(float v) {
#pragma unroll
    for (int o = 1; o < 64; o <<= 1) v = fmaxf(v, __shfl_xor(v, o));
    return v;
}

__global__ void __launch_bounds__(256) rmsnorm_rows(const float* x, const float* g, float* out, int rows) {
    const int lane = threadIdx.x & 63, w = (blockIdx.x * blockDim.x + threadIdx.x) >> 6;
    if (w >= rows) return;
    const float4* xr = (const float4*)(x + (size_t)w * DM);
    float4 v[4]; float s = 0.f;
#pragma unroll
    for (int j = 0; j < 4; ++j) { v[j] = xr[lane + 64 * j]; s += v[j].x * v[j].x + v[j].y * v[j].y + v[j].z * v[j].z + v[j].w * v[j].w; }
    s = wave_sum(s);
    const float r = 1.0f / sqrtf(s * (1.0f / DM) + EPS);
    float4* orow = (float4*)(out + (size_t)w * DM);
#pragma unroll
    for (int j = 0; j < 4; ++j) { const float4 gg = ((const float4*)g)[lane + 64 * j]; float4 o; o.x = v[j].x * r * gg.x; o.y = v[j].y * r * gg.y; o.z = v[j].z * r * gg.z; o.w = v[j].w * r * gg.w; orow[lane + 64 * j] = o; }
}

template <int ACCUM>
__global__ void __launch_bounds__(256) sgemm(const float* __restrict__ A, const float* __restrict__ B, float* C, int M, int N, int K) {
    __shared__ float As[16][132];
    __shared__ float Bs[16][132];
    const int tid = threadIdx.x, tx = tid & 15, ty = tid >> 4;
    const int m0 = blockIdx.y * 128, n0 = blockIdx.x * 128;
    float acc[8][8];
#pragma unroll
    for (int i = 0; i < 8; ++i)
#pragma unroll
        for (int j = 0; j < 8; ++j) acc[i][j] = 0.f;
    const int ar = tid >> 2, ac = (tid & 3) * 4;
    const int br = tid >> 5, bc = (tid & 31) * 4;
    for (int k0 = 0; k0 < K; k0 += 16) {
        const float4 a0 = *(const float4*)(A + (size_t)(m0 + ar) * K + k0 + ac);
        const float4 a1 = *(const float4*)(A + (size_t)(m0 + ar + 64) * K + k0 + ac);
        const float4 b0 = *(const float4*)(B + (size_t)(k0 + br) * N + n0 + bc);
        const float4 b1 = *(const float4*)(B + (size_t)(k0 + br + 8) * N + n0 + bc);
        __syncthreads();
        As[ac + 0][ar] = a0.x; As[ac + 1][ar] = a0.y; As[ac + 2][ar] = a0.z; As[ac + 3][ar] = a0.w;
        As[ac + 0][ar + 64] = a1.x; As[ac + 1][ar + 64] = a1.y; As[ac + 2][ar + 64] = a1.z; As[ac + 3][ar + 64] = a1.w;
        *(float4*)&Bs[br][bc] = b0; *(float4*)&Bs[br + 8][bc] = b1;
        __syncthreads();
#pragma unroll
        for (int k = 0; k < 16; ++k) {
            const float4 x0 = *(const float4*)&As[k][ty * 4], x1 = *(const float4*)&As[k][64 + ty * 4];
            const float4 y0 = *(const float4*)&Bs[k][tx * 4], y1 = *(const float4*)&Bs[k][64 + tx * 4];
            const float a[8] = {x0.x, x0.y, x0.z, x0.w, x1.x, x1.y, x1.z, x1.w};
            const float b[8] = {y0.x, y0.y, y0.z, y0.w, y1.x, y1.y, y1.z, y1.w};
#pragma unroll
            for (int i = 0; i < 8; ++i)
#pragma unroll
                for (int j = 0; j < 8; ++j) acc[i][j] = fmaf(a[i], b[j], acc[i][j]);
        }
    }
#pragma unroll
    for (int i = 0; i < 8; ++i) {
        const int r = m0 + (i < 4 ? ty * 4 + i : 64 + ty * 4 + (i - 4));
#pragma unroll
        for (int jh = 0; jh < 2; ++jh) {
            float* p = C + (size_t)r * N + n0 + jh * 64 + tx * 4;
            float4 o; o.x = acc[i][jh * 4 + 0]; o.y = acc[i][jh * 4 + 1]; o.z = acc[i][jh * 4 + 2]; o.w = acc[i][jh * 4 + 3];
            if (ACCUM) { const float4 c = *(const float4*)p; o.x += c.x; o.y += c.y; o.z += c.z; o.w += c.w; }
            *(float4*)p = o;
        }
    }
}

__device__ __forceinline__ float gelu_exact(float v) { return 0.5f * v * (1.0f + erff(v * 0.70710678118654752f)); }

__global__ void __launch_bounds__(256) mixer_vn(const float* P, const float* g, const float* bta, float* VN, int rows) {
    const int lane = threadIdx.x & 63, w = (blockIdx.x * blockDim.x + threadIdx.x) >> 6;
    if (w >= rows) return;
    const float* pr = P + (size_t)w * NIN + AW;
    float v[8]; float s = 0.f;
#pragma unroll
    for (int j = 0; j < 8; ++j) { v[j] = gelu_exact(pr[lane + 64 * j]); s += v[j]; }
    const float mu = wave_sum(s) * (1.0f / AW);
    float q = 0.f;
#pragma unroll
    for (int j = 0; j < 8; ++j) { v[j] -= mu; q += v[j] * v[j]; }
    const float rs = 1.0f / sqrtf(wave_sum(q) * (1.0f / AW) + EPS);
#pragma unroll
    for (int j = 0; j < 8; ++j) VN[(size_t)w * AW + lane + 64 * j] = v[j] * rs * g[lane + 64 * j] + bta[lane + 64 * j];
}

__global__ void __launch_bounds__(256) mixer_out(const float* P, const float* VN, const float* Wsp, const float* bsp, const float* cw, float* Y, int rows) {
    const int idx = blockIdx.x * blockDim.x + threadIdx.x;
    if (idx >= rows * DM) return;
    const int r = idx >> 10, c = idx & 1023;
    if (c < AW) {
        const int g = c >> 7, p = r & 127, r0 = r & ~127;
        const float* wrow = Wsp + ((size_t)g * CHUNK + p) * CHUNK;
        float s = 0.f;
        for (int q = 0; q < CHUNK; ++q) s = fmaf(wrow[q], VN[(size_t)(r0 + q) * AW + c], s);
        s += bsp[g * CHUNK + p];
        Y[(size_t)r * DM + c] = gelu_exact(P[(size_t)r * NIN + c]) * s;
    } else {
        const int cc = c - AW;
        const float* pr = P + (size_t)r * NIN;
        float conv = pr[1536 + cc] * pr[2048 + cc] * cw[BW + cc];
        if (r > 0) conv += pr[1536 + cc - NIN] * pr[2048 + cc - NIN] * cw[cc];
        if (r < rows - 1) conv += pr[1536 + cc + NIN] * pr[2048 + cc + NIN] * cw[2 * BW + cc];
        Y[(size_t)r * DM + c] = pr[1024 + cc] * conv;
    }
}

__global__ void __launch_bounds__(256) swiglu_act(float* G, const float* U, int n) {
    const int i = blockIdx.x * blockDim.x + threadIdx.x;
    if (i >= n) return;
    const float g = G[i];
    G[i] = g / (1.0f + expf(-g)) * U[i];
}

__device__ __forceinline__ int t5_bucket(int rel) {
    const int n = rel < 0 ? -rel : rel;
    int b;
    if (n < 8) b = n;
    else { const int n2 = n * n; const int lg = 31 - __clz(n2); b = 8 + (lg - 6); if (b > 15) b = 15; }
    return (rel > 0 ? 16 : 0) + b;
}

__global__ void __launch_bounds__(256) attn_naive(const float* QKV, const float* sink, const float* relb, float* O, int rows) {
    __shared__ float pbuf[4][320];
    __shared__ float qbuf[4][64];
    const int lane = threadIdx.x & 63, wl = threadIdx.x >> 6, w = (blockIdx.x * blockDim.x + threadIdx.x) >> 6;
    if (w >= rows * NH) return;
    const int s = w / NH, h = w % NH, kvh = h / 4;
    qbuf[wl][lane] = QKV[(size_t)s * NQKV + h * HD + lane];
    __builtin_amdgcn_s_waitcnt(0);
    const int j0 = s - WIN;
    float sc[5]; float mx = -INFINITY;
#pragma unroll
    for (int t = 0; t < 5; ++t) {
        const int jj = lane + 64 * t, j = j0 + jj;
        sc[t] = -INFINITY;
        if (jj <= 2 * WIN && j >= 0 && j < rows) {
            const float* kr = QKV + (size_t)j * NQKV + NH * HD + kvh * HD;
            float d = 0.f;
            for (int e = 0; e < HD; ++e) d = fmaf(qbuf[wl][e], kr[e], d);
            sc[t] = d * 0.125f + relb[t5_bucket(j - s) * NH + h];
            mx = fmaxf(mx, sc[t]);
        }
    }
    const float sk = sink[h];
    const float m = fmaxf(wave_max(mx), sk);
    float psum = 0.f;
#pragma unroll
    for (int t = 0; t < 5; ++t) { const float p = (sc[t] == -INFINITY) ? 0.f : expf(sc[t] - m); pbuf[wl][lane + 64 * t] = p; psum += p; }
    const float denom = wave_sum(psum) + expf(sk - m);
    __builtin_amdgcn_s_waitcnt(0);
    float o = 0.f;
    for (int jj = 0; jj <= 2 * WIN; ++jj) {
        const int j = j0 + jj;
        if (j < 0 || j >= rows) continue;
        o = fmaf(pbuf[wl][jj], QKV[(size_t)j * NQKV + (NH + NKV) * HD + kvh * HD + lane], o);
    }
    O[(size_t)s * DM + h * HD + lane] = o / denom;
}

}


#ifndef MK_OPT_PHASES
#define MK_OPT_PHASES 12
#endif
#ifndef MK_ONE_LAUNCH
#define MK_ONE_LAUNCH 1
#endif
constexpr size_t OR_BASE = 320 * MiB;
constexpr size_t OR_H = OR_BASE, OR_P = OR_H + 16 * MiB, OR_Y = OR_P + 88 * MiB, OR_VN = OR_Y + 16 * MiB, OR_END = OR_VN + 8 * MiB;

namespace simple {
__global__ void __launch_bounds__(256) cvt_bf16_f32(const unsigned short* src, float* dst, int rows, int cols, int sld, int dld, float scale) {
    const int idx = blockIdx.x * blockDim.x + threadIdx.x; if (idx >= rows * cols) return;
    const int r = idx / cols, c = idx - r * cols;
    dst[(size_t)r * dld + c] = __builtin_bit_cast(float, (unsigned)src[(size_t)r * sld + c] << 16) * scale;
}
}
static void simple_gemm(hipStream_t st, const float* A, const float* B, float* C, int M, int N, int K, bool accum) {
    dim3 grid(N / 128, M / 128);
    if (accum) hipLaunchKernelGGL(simple::sgemm<1>, grid, dim3(256), 0, st, A, B, C, M, N, K);
    else hipLaunchKernelGGL(simple::sgemm<0>, grid, dim3(256), 0, st, A, B, C, M, N, K);
}
static void simple_cvt(hipStream_t st, const void* src, float* dst, int rows, int cols, int sld, int dld, float scale) {
    hipLaunchKernelGGL(simple::cvt_bf16_f32, dim3((rows * cols + 255) / 256), dim3(256), 0, st, (const unsigned short*)src, dst, rows, cols, sld, dld, scale);
}

extern "C" void kernel_launch(void* const* d_in, const int* in_sizes, int n_in, void* d_out, int out_size, void* d_ws, size_t ws_size, hipStream_t stream) {
    constexpr int KOPT = MK_OPT_PHASES;
    static int grid = 0;
    if (grid == 0) {
        if (n_in != 18 || in_sizes[0] != MTOK * DM || out_size != MTOK * DM || ws_size < OR_END) { fprintf(stderr, "kernel_launch: unexpected shapes / workspace (%d inputs, out %d, ws %zu)\n", n_in, out_size, ws_size); grid = -1; return; }
        int dev = 0, cus = 0, per_cu = 0;
        if (hipGetDevice(&dev) != hipSuccess || hipDeviceGetAttribute(&cus, hipDeviceAttributeMultiprocessorCount, dev) != hipSuccess) { grid = -1; return; }
        if (hipFuncSetAttribute((const void*)mk_fwd, hipFuncAttributeMaxDynamicSharedMemorySize, LDS_BYTES) != hipSuccess) { fprintf(stderr, "kernel_launch: hipFuncSetAttribute failed\n"); grid = -1; return; }
        if (hipOccupancyMaxActiveBlocksPerMultiprocessor(&per_cu, (const void*)mk_fwd, NWAVES * 64, LDS_BYTES) != hipSuccess || per_cu < 1) { fprintf(stderr, "kernel_launch: occupancy query says %d blocks per CU\n", per_cu); (void)hipGetLastError(); grid = -1; return; }
        if (cus != 256) { fprintf(stderr, "kernel_launch: built for a 256-CU device, found %d\n", cus); grid = -1; return; }
        grid = cus;
    }
    if (grid < 0) return;
    const float* const* in = (const float* const*)d_in;
    float* out = (float*)d_out; unsigned char* ws = (unsigned char*)d_ws;
    if (KOPT > 0) {
        (void)hipMemsetAsync(ws + WS_CTL, 0, CTL_ZERO_BYTES, stream);
        Args a{};
        for (int i = 0; i < 18; ++i) a.in[i] = in[i];
        a.out = out; a.ws = ws;
        if (KOPT == N_PHASES && MK_ONE_LAUNCH) { a.ph_lo = 0; a.ph_hi = N_PHASES; a.use_bar = 1; hipLaunchKernelGGL(mk_fwd, dim3(grid), dim3(NWAVES * 64), LDS_BYTES, stream, a); }
        else for (int p = 0; p < KOPT; ++p) { a.ph_lo = p; a.ph_hi = p + 1; a.use_bar = 0; hipLaunchKernelGGL(mk_fwd, dim3(grid), dim3(NWAVES * 64), LDS_BYTES, stream, a); }
    }
    if (KOPT >= N_PHASES) return;
    const float* x = in[0]; const float* norm_mix = in[1]; const float* norm_ffn = in[2]; const float* w_in = in[3]; const float* vln_g = in[4]; const float* vln_b = in[5];
    const float* w_sp = in[6]; const float* b_sp = in[7]; const float* conv_w = in[8]; const float* w_out0 = in[9]; const float* w_qkv = in[10]; const float* sink = in[11];
    const float* relb = in[12]; const float* w_out1 = in[13]; const float* w_gate = in[14]; const float* w_up = in[15]; const float* w_down = in[16]; const float* fin = in[17];
    float* H = (float*)(ws + OR_H); float* P = (float*)(ws + OR_P); float* Y = (float*)(ws + OR_Y); float* VN = (float*)(ws + OR_VN);
    float* P2 = P + (size_t)SEQ * DFF;
    const int s0 = KOPT < 3 ? 0 : KOPT - 2;
    if (KOPT < 4) (void)hipMemcpyAsync(out, x, (size_t)MTOK * DM * sizeof(float), hipMemcpyDeviceToDevice, stream);
    const int rows = SEQ, rb = rows * 64 / 256;
    for (int b = 0; b < BATCH; ++b) {
        float* xr = out + (size_t)b * SEQ * DM; const size_t r0 = (size_t)b * SEQ;
        if (s0 <= 0) {
            hipLaunchKernelGGL(simple::rmsnorm_rows, dim3(rb), dim3(256), 0, stream, (const float*)xr, norm_mix, H, rows);
            simple_gemm(stream, H, w_in, P, rows, NIN, DM, false);
            hipLaunchKernelGGL(simple::mixer_vn, dim3(rb), dim3(256), 0, stream, (const float*)P, vln_g, vln_b, VN, rows);
            hipLaunchKernelGGL(simple::mixer_out, dim3(rows * DM / 256), dim3(256), 0, stream, (const float*)P, (const float*)VN, w_sp, b_sp, conv_w, Y, rows);
        }
        if (s0 == 1) simple_cvt(stream, ws + WS_Y + r0 * DM * 2, Y, rows, DM, DM, DM, 1.0f);
        if (s0 <= 1) simple_gemm(stream, Y, w_out0, xr, rows, DM, DM, true);
        if (s0 <= 2) {
            hipLaunchKernelGGL(simple::rmsnorm_rows, dim3(rb), dim3(256), 0, stream, (const float*)xr, norm_ffn, H, rows);
            simple_gemm(stream, H, w_gate, P, rows, DFF, DM, false);
            simple_gemm(stream, H, w_up, P2, rows, DFF, DM, false);
            hipLaunchKernelGGL(simple::swiglu_act, dim3(rows * DFF / 256), dim3(256), 0, stream, P, (const float*)P2, rows * DFF);
        }
        if (s0 == 3) simple_cvt(stream, ws + WS_ACT + r0 * DFF * 2, P, rows, DFF, DFF, DFF, 1.0f);
        if (s0 <= 3) simple_gemm(stream, P, w_down, xr, rows, DM, DFF, true);
        if (s0 <= 4) {
            hipLaunchKernelGGL(simple::rmsnorm_rows, dim3(rb), dim3(256), 0, stream, (const float*)xr, norm_mix + DM, H, rows);
            simple_gemm(stream, H, w_qkv, P, rows, NQKV, DM, false);
        }
        if (s0 == 5) { simple_cvt(stream, ws + WS_Q + r0 * DM * 2, P, rows, DM, DM, NQKV, 1.0f / ATT_C2);
                       simple_cvt(stream, ws + WS_K + r0 * 256 * 2, P + 1024, rows, 256, 256, NQKV, 1.0f);
                       simple_cvt(stream, ws + WS_VV + r0 * 256 * 2, P + 1280, rows, 256, 256, NQKV, 1.0f); }
        if (s0 <= 5) hipLaunchKernelGGL(simple::attn_naive, dim3(rows * NH / 4), dim3(256), 0, stream, (const float*)P, sink, relb, Y, rows);
        if (s0 == 6) simple_cvt(stream, ws + WS_O + r0 * DM * 2, Y, rows, DM, DM, DM, 1.0f);
        if (s0 <= 6) simple_gemm(stream, Y, w_out1, xr, rows, DM, DM, true);
        if (s0 <= 7) {
            hipLaunchKernelGGL(simple::rmsnorm_rows, dim3(rb), dim3(256), 0, stream, (const float*)xr, norm_ffn + DM, H, rows);
            simple_gemm(stream, H, w_gate + (size_t)DM * DFF, P, rows, DFF, DM, false);
            simple_gemm(stream, H, w_up + (size_t)DM * DFF, P2, rows, DFF, DM, false);
            hipLaunchKernelGGL(simple::swiglu_act, dim3(rows * DFF / 256), dim3(256), 0, stream, P, (const float*)P2, rows * DFF);
        }
        if (s0 == 8) simple_cvt(stream, ws + WS_ACT + r0 * DFF * 2, P, rows, DFF, DFF, DFF, 1.0f);
        if (s0 <= 8) simple_gemm(stream, P, w_down + (size_t)DFF * DM, xr, rows, DM, DFF, true);
        hipLaunchKernelGGL(simple::rmsnorm_rows, dim3(rb), dim3(256), 0, stream, (const float*)xr, fin, xr, rows);
    }
}
```
